# Optimizing an MI355X kernel written in HIP

```python
import jax, jax.numpy as jnp
from jax import lax
import numpy as np

D_MODEL = 2048
BATCH = 4
SEQ = 4096
DEPTH = 2

MLSTM_HEADS = 4
MLSTM_QK_DIM = 256
MLSTM_V_DIM = 512
MLSTM_QK_WIDTH = MLSTM_HEADS * MLSTM_QK_DIM
MLSTM_WIDTH = MLSTM_HEADS * MLSTM_V_DIM
CHUNK = 64
N_GATE_COLS = 4 * MLSTM_HEADS
LRU_WIDTH = D_MODEL
LRU_BLOCKS = 16
LRU_BLOCK_DIM = LRU_WIDTH // LRU_BLOCKS
LRU_C = 8.0
CONV_W = 4
CONV_LEFT = 2
N_DIR = 2
NORM_EPS = 1e-6
N_IN = 2 * MLSTM_QK_WIDTH + 3 * MLSTM_WIDTH + N_GATE_COLS + 2 * LRU_WIDTH + 2 * D_MODEL

kernel_name = "hybrid_mlstm_rglru_gated_parallel_encoder"


def _rms_norm(x, g):
    xf = x.astype(jnp.float32)
    y = xf * lax.rsqrt(jnp.mean(xf * xf, axis=-1, keepdims=True) + NORM_EPS)
    return (y * g.astype(jnp.float32)).astype(x.dtype)


def _to_heads(t, head_dim):
    b, s, _ = t.shape
    return t.reshape(b, s, -1, head_dim).transpose(0, 2, 1, 3).astype(jnp.float32)


def _mlstm_one_direction(q, k, v, i_pre, f_pre):
    bsz, nh, s, _ = q.shape
    nc = s // CHUNK

    def chunks(t):
        return jnp.moveaxis(t.reshape((bsz, nh, nc, CHUNK) + t.shape[3:]), 2, 0)

    b_cum = jnp.cumsum(chunks(jax.nn.log_sigmoid(f_pre)), axis=-1)
    lower = jnp.tril(jnp.ones((CHUNK, CHUNK), dtype=bool))

    def step(carry, xs):
        c_st, n_st, m_st = carry
        qc, kc, vc, ic, bc = xs
        d_log = jnp.where(lower, bc[..., :, None] - bc[..., None, :] + ic[..., None, :], -jnp.inf)
        inter_log = bc + m_st[..., None]
        m_row = jnp.maximum(inter_log, jnp.max(d_log, axis=-1))
        w_intra = jnp.exp(d_log - m_row[..., None])
        w_inter = jnp.exp(inter_log - m_row)
        scores = jnp.einsum('bhjk,bhsk->bhjs', qc, kc) * w_intra
        num = (jnp.einsum('bhjs,bhsv->bhjv', scores, vc)
               + w_inter[..., None] * jnp.einsum('bhjk,bhvk->bhjv', qc, c_st))
        den = jnp.sum(scores, axis=-1) + w_inter * jnp.einsum('bhjk,bhk->bhj', qc, n_st)
        h = num / jnp.maximum(jnp.abs(den), jnp.exp(-m_row))[..., None]
        g_tot = bc[..., -1]
        w_log = g_tot[..., None] - bc + ic
        m_new = jnp.maximum(g_tot + m_st, jnp.max(w_log, axis=-1))
        w_k = jnp.exp(w_log - m_new[..., None])
        decay = jnp.exp(g_tot + m_st - m_new)
        c_new = decay[..., None, None] * c_st + jnp.einsum('bhsv,bhsk->bhvk', vc * w_k[..., None], kc)
        n_new = decay[..., None] * n_st + jnp.einsum('bhs,bhsk->bhk', w_k, kc)
        return (c_new, n_new, m_new), h

    init = (jnp.zeros((bsz, nh, MLSTM_V_DIM, MLSTM_QK_DIM), jnp.float32),
            jnp.zeros((bsz, nh, MLSTM_QK_DIM), jnp.float32),
            jnp.zeros((bsz, nh), jnp.float32))
    _, h = lax.scan(step, init, (chunks(q), chunks(k), chunks(v), chunks(i_pre), b_cum))
    return jnp.moveaxis(h, 0, 2).reshape(bsz, nh, s, MLSTM_V_DIM)


def _mlstm_branch(q_p, k_p, v_p, o_p, z_p, gif_p, b_if, head_g):
    bsz, s, _ = v_p.shape
    q = _to_heads(q_p, MLSTM_QK_DIM)
    k = _to_heads(k_p, MLSTM_QK_DIM) * (MLSTM_QK_DIM ** -0.5)
    v = _to_heads(v_p, MLSTM_V_DIM)
    gates = (gif_p.astype(jnp.float32) + b_if.astype(jnp.float32)).transpose(0, 2, 1)
    i_f, i_b, f_f, f_b = jnp.split(gates, 4, axis=1)
    flip = lambda t: jnp.flip(t, axis=2)
    h_fwd = _mlstm_one_direction(q, k, v, i_f, f_f)
    h_bwd = flip(_mlstm_one_direction(flip(q), flip(k), flip(v), flip(i_b), flip(f_b)))
    h = h_fwd + h_bwd
    h = h * lax.rsqrt(jnp.mean(h * h, axis=-1, keepdims=True) + NORM_EPS)
    h = h.transpose(0, 2, 1, 3).reshape(bsz, s, MLSTM_WIDTH) * head_g.astype(jnp.float32)
    h = h * jax.nn.sigmoid(o_p.astype(jnp.float32)) * jax.nn.silu(z_p.astype(jnp.float32))
    return h.astype(v_p.dtype)


def _rglru_one_direction(xc, w_r, b_r, w_i, b_i, lam, reverse):
    bsz, s, w = xc.shape
    xb = xc.reshape(bsz, s, LRU_BLOCKS, LRU_BLOCK_DIM)
    r = jax.nn.sigmoid(jnp.einsum('bsnc,ncd->bsnd', xb, w_r.astype(jnp.float32)).reshape(bsz, s, w)
                       + b_r.astype(jnp.float32))
    i = jax.nn.sigmoid(jnp.einsum('bsnc,ncd->bsnd', xb, w_i.astype(jnp.float32)).reshape(bsz, s, w)
                       + b_i.astype(jnp.float32))
    log_a = -LRU_C * r * jax.nn.softplus(-lam.astype(jnp.float32))
    a = jnp.exp(log_a)
    u = jnp.sqrt(-jnp.expm1(2.0 * log_a)) * (i * xc)

    def combine(left, right):
        a1, b1 = left
        a2, b2 = right
        return a1 * a2, a2 * b1 + b2

    _, h = lax.associative_scan(combine, (a, u), reverse=reverse, axis=1)
    return h


def _rglru_branch(x_p, z_p, conv_w, conv_b, w_rg, b_rg, lam):
    s = x_p.shape[1]
    xf = x_p.astype(jnp.float32)
    xpad = jnp.pad(xf, ((0, 0), (CONV_LEFT, CONV_W - 1 - CONV_LEFT), (0, 0)))
    cw = conv_w.astype(jnp.float32)
    xc = conv_b.astype(jnp.float32) + sum(xpad[:, t:t + s] * cw[t] for t in range(CONV_W))
    h = (_rglru_one_direction(xc, w_rg[0, 0], b_rg[0, 0], w_rg[0, 1], b_rg[0, 1], lam[0], False)
         + _rglru_one_direction(xc, w_rg[1, 0], b_rg[1, 0], w_rg[1, 1], b_rg[1, 1], lam[1], True))
    return (h * jax.nn.silu(z_p.astype(jnp.float32))).astype(x_p.dtype)


def _hybrid_layer(x, norm_g, w_in, b_if, head_g, conv_w, conv_b, w_rg, b_rg, lam,
                  w_branch_a, w_branch_b, w_out):
    h = _rms_norm(x, norm_g)
    proj = jnp.einsum('bsd,dn->bsn', h, w_in.astype(h.dtype))
    sizes = [MLSTM_QK_WIDTH, MLSTM_QK_WIDTH, MLSTM_WIDTH, MLSTM_WIDTH, MLSTM_WIDTH,
             N_GATE_COLS, LRU_WIDTH, LRU_WIDTH, D_MODEL]
    cuts = [int(c) for c in np.cumsum(sizes)]
    q_p, k_p, v_p, o_p, za_p, gif_p, xb_p, zb_p, ga_p, gb_p = jnp.split(proj, cuts, axis=-1)
    ya = _mlstm_branch(q_p, k_p, v_p, o_p, za_p, gif_p, b_if, head_g)
    yb = _rglru_branch(xb_p, zb_p, conv_w, conv_b, w_rg, b_rg, lam)
    ya = jnp.einsum('bsw,wd->bsd', ya, w_branch_a.astype(ya.dtype))
    yb = jnp.einsum('bsw,wd->bsd', yb, w_branch_b.astype(yb.dtype))
    merged = (jax.nn.sigmoid(ga_p.astype(jnp.float32)) * ya.astype(jnp.float32)
              + jax.nn.sigmoid(gb_p.astype(jnp.float32)) * yb.astype(jnp.float32)).astype(x.dtype)
    return x + jnp.einsum('bsd,de->bse', merged, w_out.astype(x.dtype))


def setup_inputs(seed: int = 0) -> dict:
    key = jax.random.key(seed)
    ks = jax.random.split(key, 16)
    f32 = jnp.float32
    nrm = lambda k, shape, scale: jax.random.normal(k, shape, f32) * scale
    x = jax.random.normal(ks[0], (BATCH, SEQ, D_MODEL), f32)
    norm_g = 1.0 + nrm(ks[1], (DEPTH, D_MODEL), 0.02)
    w_in = nrm(ks[2], (DEPTH, D_MODEL, N_IN), D_MODEL ** -0.5)
    i_bias = nrm(ks[3], (DEPTH, 2 * MLSTM_HEADS), 0.1)
    f_bias = 3.0 + 3.0 * jax.random.uniform(ks[4], (DEPTH, 2 * MLSTM_HEADS), f32)
    b_if = jnp.concatenate([i_bias, f_bias], axis=-1)
    head_g = 1.0 + nrm(ks[5], (DEPTH, MLSTM_WIDTH), 0.02)
    conv_w = nrm(ks[6], (DEPTH, CONV_W, LRU_WIDTH), CONV_W ** -0.5)
    conv_b = nrm(ks[7], (DEPTH, LRU_WIDTH), 0.02)
    w_rg = nrm(ks[8], (DEPTH, N_DIR, 2, LRU_BLOCKS, LRU_BLOCK_DIM, LRU_BLOCK_DIM), LRU_BLOCK_DIM ** -0.5)
    b_rg = nrm(ks[9], (DEPTH, N_DIR, 2, LRU_WIDTH), 0.02)
    u = jax.random.uniform(ks[10], (DEPTH, N_DIR, LRU_WIDTH), f32, 0.9, 0.999)
    lru_lambda = jnp.log(u) - jnp.log1p(-u)
    w_branch_a = nrm(ks[11], (DEPTH, MLSTM_WIDTH, D_MODEL), MLSTM_WIDTH ** -0.5)
    w_branch_b = nrm(ks[12], (DEPTH, LRU_WIDTH, D_MODEL), LRU_WIDTH ** -0.5)
    w_out = nrm(ks[13], (DEPTH, D_MODEL, D_MODEL), D_MODEL ** -0.5)
    final_g = 1.0 + nrm(ks[14], (D_MODEL,), 0.02)
    return {"x": x, "norm_g": norm_g, "w_in": w_in, "b_if": b_if, "head_g": head_g,
            "conv_w": conv_w, "conv_b": conv_b, "w_rg": w_rg, "b_rg": b_rg,
            "lru_lambda": lru_lambda, "w_branch_a": w_branch_a, "w_branch_b": w_branch_b,
            "w_out": w_out, "final_g": final_g}


def reference(x, norm_g, w_in, b_if, head_g, conv_w, conv_b, w_rg, b_rg, lru_lambda,
              w_branch_a, w_branch_b, w_out, final_g):
    h = x
    for layer in range(DEPTH):
        h = _hybrid_layer(h, norm_g[layer], w_in[layer], b_if[layer], head_g[layer],
                          conv_w[layer], conv_b[layer], w_rg[layer], b_rg[layer],
                          lru_lambda[layer], w_branch_a[layer], w_branch_b[layer], w_out[layer])
    return _rms_norm(h, final_g)
```

```cpp
#include <hip/hip_runtime.h>
#include <hip/hip_cooperative_groups.h>
#include <cstdio>
#include <cstdint>
namespace cg = cooperative_groups;

#ifndef COOP
#define COOP 0
#endif

typedef unsigned short u16;
using bf16x8 = __attribute__((ext_vector_type(8))) short;
using u16x4 = __attribute__((ext_vector_type(4))) unsigned short;
using f32x4 = __attribute__((ext_vector_type(4))) float;
using f32x16 = __attribute__((ext_vector_type(16))) float;

constexpr int T = 16384, SEQ = 4096, DM = 2048, NIN = 16400;
constexpr float EPS = 1e-6f;
constexpr size_t MiB = 1ull << 20;
constexpr size_t WS_WT0 = 0;
constexpr size_t WS_WT1 = 64 * MiB;
constexpr size_t WS_WSM = 128 * MiB;
constexpr size_t WSM_STRIDE = 27 * MiB;
constexpr size_t WS_Q = 182 * MiB, WS_K = 214 * MiB, WS_KT = 246 * MiB, WS_VT = 278 * MiB, WS_O = 342 * MiB,
                 WS_ZA = 406 * MiB, WS_XBP = 470 * MiB, WS_ZB = 534 * MiB, WS_GA = 598 * MiB, WS_GB = 662 * MiB,
                 WS_XB16 = 726 * MiB,
                 WS_LHF = 790 * MiB, WS_LHB = 854 * MiB, WS_RS = 918 * MiB, WS_GATES = 918 * MiB + 65536,
                 WS_END = 920 * MiB;
constexpr int LDS_BYTES = 160 * 1024;

struct Params {
  const float *x, *norm_g, *w_in, *b_if, *head_g, *conv_w, *conv_b, *w_rg, *b_rg, *lam, *w_a, *w_b, *w_o, *final_g;
  float* out;
  unsigned char* ws;
};

__device__ __forceinline__ u16 f2bf(float f) {
  uint32_t u = __float_as_uint(f);
  u += 0x7fffu + ((u >> 16) & 1u);
  return (u16)(u >> 16);
}
__device__ __forceinline__ float bf2f(u16 h) { return __uint_as_float(((uint32_t)h) << 16); }
__device__ __forceinline__ int fresh_lane() {
  int l;
  asm volatile("v_mbcnt_lo_u32_b32 %0, -1, 0\n\tv_mbcnt_hi_u32_b32 %0, -1, %0" : "=v"(l));
  return l & 63;
}
#define TID_DECL const int tid = wave * 64 + fresh_lane()
__device__ __forceinline__ float sigmoidf_(float x) { return 1.f / (1.f + __expf(-x)); }

__device__ __forceinline__ void tconv_tile(const float* __restrict__ src, long ld_src, int k0, int n0s, u16* __restrict__ dst,
                           long ld_dst, int n0d, const float* __restrict__ rowscale, float cs, float* tile, int wave) {
  TID_DECL;
  int c = tid & 63, r = tid >> 6;
#pragma unroll
  for (int i = 0; i < 8; ++i) {
    int kl = r + 8 * i;
    float v = src[(long)(k0 + kl) * ld_src + n0s + c];
    if (rowscale) v *= rowscale[k0 + kl];
    tile[kl * 65 + c] = v * cs;
  }
  __syncthreads();
#pragma unroll
  for (int i = 0; i < 8; ++i) {
    int nl = r + 8 * i;
    dst[(long)(n0d + nl) * ld_dst + k0 + c] = f2bf(tile[c * 65 + nl]);
  }
  __syncthreads();
}

__device__ __forceinline__ void phase_convert(const Params& p, char* lds, int wave) {
  TID_DECL;
  float* tile = (float*)lds;
  constexpr int PER_LAYER = 8192 + 3072 + 256 + 1;
  for (int it = blockIdx.x; it < 2 * PER_LAYER; it += gridDim.x) {
    int l = it / PER_LAYER, r = it % PER_LAYER;
    unsigned char* wsm = p.ws + WS_WSM + (size_t)l * WSM_STRIDE;
    if (r < 8192) {
      int kt = r & 31, nt = r >> 5;
      int n0d = nt * 64, n0s = n0d < 8192 ? n0d : n0d + 16;
      float cs = (n0d >= 1024 && n0d < 2048) ? 0.0625f : 1.f;
      u16* dst = (u16*)(p.ws + (l ? WS_WT1 : WS_WT0));
      tconv_tile(p.w_in + (size_t)l * DM * NIN, NIN, kt * 64, n0s, dst, DM, n0d, p.norm_g + l * DM, cs, tile, wave);
    } else if (r < 8192 + 3072) {
      int q = r - 8192, which = q >> 10, tt = q & 1023, kt = tt & 31, nt = tt >> 5;
      const float* src = (which == 0 ? p.w_a : which == 1 ? p.w_b : p.w_o) + (size_t)l * DM * DM;
      u16* dst = (u16*)(wsm + (size_t)which * 8 * MiB);
      tconv_tile(src, DM, kt * 64, nt * 64, dst, DM, nt * 64, nullptr, 1.f, tile, wave);
    } else if (r < 8192 + 3072 + 256) {
      int q = r - 8192 - 3072, mat = q >> 2, tt = q & 3;
      const float* src = p.w_rg + ((size_t)l * 64 + mat) * 16384;
      u16* dst = (u16*)(wsm + 24 * MiB) + (size_t)mat * 16384;
      tconv_tile(src, 128, (tt & 1) * 64, (tt >> 1) * 64, dst, 128, (tt >> 1) * 64, nullptr, 1.f, tile, wave);
    } else {
      u16* dst = (u16*)(wsm + 26 * MiB);
      const float* src = p.w_in + (size_t)l * DM * NIN;
      for (int i = tid; i < 16 * DM; i += 512) {
        int j = i >> 11, k = i & 2047;
        dst[i] = f2bf(src[(size_t)k * NIN + 8192 + j] * p.norm_g[l * DM + k]);
      }
    }
  }
}

__device__ __forceinline__ void phase_rowpass(const Params& p, int layer, const float* __restrict__ xin, int wave) {
  int lane = fresh_lane(), wid = wave;
  int gw = blockIdx.x * 8 + wid, nw = gridDim.x * 8;
  int r = lane & 15, q = lane >> 4;
  u16* xb16 = (u16*)(p.ws + WS_XB16);
  float* rs = (float*)(p.ws + WS_RS);
  float* gates = (float*)(p.ws + WS_GATES);
  const u16* wg = (const u16*)(p.ws + WS_WSM + (size_t)layer * WSM_STRIDE + 26 * MiB);
  for (int rt = gw; rt < T / 16; rt += nw) {
    int row = rt * 16 + r;
    const float* xr = xin + (size_t)row * DM + q * 8;
    f32x4 acc = {0.f, 0.f, 0.f, 0.f};
    float ss = 0.f;
#pragma unroll 4
    for (int kk = 0; kk < 64; ++kk) {
      float4 a0 = *(const float4*)(xr + kk * 32);
      float4 a1 = *(const float4*)(xr + kk * 32 + 4);
      ss += a0.x * a0.x + a0.y * a0.y + a0.z * a0.z + a0.w * a0.w + a1.x * a1.x + a1.y * a1.y + a1.z * a1.z + a1.w * a1.w;
      bf16x8 af;
      af[0] = (short)f2bf(a0.x); af[1] = (short)f2bf(a0.y); af[2] = (short)f2bf(a0.z); af[3] = (short)f2bf(a0.w);
      af[4] = (short)f2bf(a1.x); af[5] = (short)f2bf(a1.y); af[6] = (short)f2bf(a1.z); af[7] = (short)f2bf(a1.w);
      *(bf16x8*)(xb16 + (size_t)row * DM + kk * 32 + q * 8) = af;
      bf16x8 bfr = *(const bf16x8*)(wg + (size_t)r * DM + kk * 32 + q * 8);
      acc = __builtin_amdgcn_mfma_f32_16x16x32_bf16(af, bfr, acc, 0, 0, 0);
    }
    ss += __shfl_xor(ss, 16);
    ss += __shfl_xor(ss, 32);
    float rsv = rsqrtf(ss * (1.f / DM) + EPS);
    if (q == 0) rs[row] = rsv;
    float bias = p.b_if[layer * 16 + r];
#pragma unroll
    for (int j = 0; j < 4; ++j) {
      float rr = __shfl(rsv, q * 4 + j);
      gates[(size_t)(rt * 16 + q * 4 + j) * 16 + r] = acc[j] * rr + bias;
    }
  }
}

__device__ __forceinline__ void phase_final(const Params& p, int wave) {
  int lane = fresh_lane(), wid = wave;
  int gw = blockIdx.x * 8 + wid, nw = gridDim.x * 8;
  for (int row = gw; row < T; row += nw) {
    float* xr = p.out + (size_t)row * DM;
    float4 v[8];
    float ss = 0.f;
#pragma unroll
    for (int i = 0; i < 8; ++i) {
      v[i] = *(const float4*)(xr + i * 256 + lane * 4);
      ss += v[i].x * v[i].x + v[i].y * v[i].y + v[i].z * v[i].z + v[i].w * v[i].w;
    }
#pragma unroll
    for (int o = 32; o >= 1; o >>= 1) ss += __shfl_xor(ss, o);
    float rsv = rsqrtf(ss * (1.f / DM) + EPS);
#pragma unroll
    for (int i = 0; i < 8; ++i) {
      float4 g = *(const float4*)(p.final_g + i * 256 + lane * 4);
      float4 o4;
      o4.x = v[i].x * rsv * g.x; o4.y = v[i].y * rsv * g.y; o4.z = v[i].z * rsv * g.z; o4.w = v[i].w * rsv * g.w;
      *(float4*)(xr + i * 256 + lane * 4) = o4;
    }
  }
}

constexpr int BM = 256, BK = 64, HALF = 128, HT = HALF * BK;
__device__ __forceinline__ int lds_byte(int r, int c) {
  int st = (r >> 4) * 2 + (c >> 5), rr = r & 15, cc = c & 31, ob = rr * 64 + cc * 2;
  return st * 1024 + (ob ^ (((ob >> 9) & 1) << 5));
}
__device__ __forceinline__ void stage_rc(int b, int& R, int& C) {
  int st = b / 1024, sb = b % 1024, swz = sb ^ (((sb >> 9) & 1) << 5);
  R = (st >> 1) * 16 + swz / 64;
  C = (st & 1) * 32 + (swz % 64) / 2;
}

typedef f32x4 acc_t[2][2][4][2];

__device__ __forceinline__ void gemm_mainloop(const u16* __restrict__ A, long lda, const u16* __restrict__ Bt, long ldb,
                                              int K, int brow, int bcol, acc_t& acc, u16* shm, int wave) {
#define SA(b, h) (shm + ((b) * 2 + (h)) * HT)
#define SB(b, h) (shm + (4 + (b) * 2 + (h)) * HT)
#define STAGE(P, BASE, LD, br, kt)                                                                             \
  do {                                                                                                         \
    const u16* _gb = (BASE) + ((size_t)(br) * 2048 + (size_t)(kt) * BK);                                       \
    __builtin_amdgcn_global_load_lds((const unsigned*)(_gb + soff0), (unsigned*)((char*)(P) + tid * 16), 16, 0, 0);        \
    __builtin_amdgcn_global_load_lds((const unsigned*)(_gb + soff1), (unsigned*)((char*)(P) + tid * 16 + 8192), 16, 0, 0); \
  } while (0)
#define LDA(dst, b, h)                                                                                         \
  _Pragma("unroll") for (int m = 0; m < 4; ++m)                                                                \
    _Pragma("unroll") for (int k = 0; k < 2; ++k)                                                              \
  dst[m][k] = *reinterpret_cast<const bf16x8*>((char*)SA(b, h) + lds_byte(wr * 64 + m * 16 + fr, k * 32 + fq * 8))
#define LDB(dst, b, h)                                                                                         \
  _Pragma("unroll") for (int n = 0; n < 2; ++n)                                                                \
    _Pragma("unroll") for (int k = 0; k < 2; ++k)                                                              \
  dst[n][k] = *reinterpret_cast<const bf16x8*>((char*)SB(b, h) + lds_byte(wc * 32 + n * 16 + fr, k * 32 + fq * 8))
#define MMA(ai, bj, At, Bt_)                                                                                   \
  do {                                                                                                         \
    __builtin_amdgcn_s_setprio(1);                                                                             \
    _Pragma("unroll") for (int m = 0; m < 4; ++m)                                                              \
      _Pragma("unroll") for (int n = 0; n < 2; ++n)                                                            \
        _Pragma("unroll") for (int k = 0; k < 2; ++k)                                                          \
          acc[ai][bj][m][n] = __builtin_amdgcn_mfma_f32_16x16x32_bf16(At[m][k], Bt_[n][k], acc[ai][bj][m][n], 0, 0, 0); \
    __builtin_amdgcn_s_setprio(0);                                                                             \
  } while (0)
#define WAIT_V(n) asm volatile("s_waitcnt vmcnt(" #n ")" ::: "memory")
#define WAIT_L(n) asm volatile("s_waitcnt lgkmcnt(" #n ")" ::: "memory")
#define BAR __builtin_amdgcn_s_barrier()
#define SCHED __builtin_amdgcn_sched_barrier(0)
  const int lane = fresh_lane(), tid = wave * 64 + lane;
  int wid = wave, wr = wid >> 2, wc = wid & 3, fr = lane & 15, fq = lane >> 4;
  bf16x8 At[4][2], B0[2][2], B1[2][2];
  int nt = K / BK;
  unsigned soff0, soff1;
  { int _r, _c; stage_rc(tid * 16, _r, _c); soff0 = _r * 2048 + _c; stage_rc(tid * 16 + 8192, _r, _c); soff1 = _r * 2048 + _c; }
  STAGE(SB(0, 0), Bt, ldb, bcol, 0); STAGE(SA(0, 0), A, lda, brow, 0);
  STAGE(SB(0, 1), Bt, ldb, bcol + HALF, 0); STAGE(SA(0, 1), A, lda, brow + HALF, 0);
  if (wr == 1) BAR;
  WAIT_V(4); BAR;
  STAGE(SB(1, 0), Bt, ldb, bcol, 1); STAGE(SA(1, 0), A, lda, brow, 1); STAGE(SB(1, 1), Bt, ldb, bcol + HALF, 1);
  WAIT_V(6); BAR;
  for (int t = 0; t < nt - 2; t += 2) {
    LDB(B0, 0, 0); SCHED; LDA(At, 0, 0); STAGE(SA(1, 1), A, lda, brow + HALF, t + 1);
    WAIT_L(8); BAR; WAIT_L(0); MMA(0, 0, At, B0); BAR; SCHED;
    LDB(B1, 0, 1); STAGE(SB(0, 0), Bt, ldb, bcol, t + 2);
    BAR; WAIT_L(0); MMA(0, 1, At, B1); BAR;
    LDA(At, 0, 1); STAGE(SA(0, 0), A, lda, brow, t + 2);
    BAR; WAIT_L(0); MMA(1, 0, At, B0); BAR; SCHED;
    STAGE(SB(0, 1), Bt, ldb, bcol + HALF, t + 2);
    WAIT_V(6); BAR; MMA(1, 1, At, B1); BAR;
    LDB(B0, 1, 0); SCHED; LDA(At, 1, 0); STAGE(SA(0, 1), A, lda, brow + HALF, t + 2);
    WAIT_L(8); BAR; WAIT_L(0); MMA(0, 0, At, B0); BAR; SCHED;
    LDB(B1, 1, 1); STAGE(SB(1, 0), Bt, ldb, bcol, t + 3);
    BAR; WAIT_L(0); MMA(0, 1, At, B1); BAR;
    LDA(At, 1, 1); STAGE(SA(1, 0), A, lda, brow, t + 3);
    BAR; WAIT_L(0); MMA(1, 0, At, B0); BAR; SCHED;
    STAGE(SB(1, 1), Bt, ldb, bcol + HALF, t + 3);
    WAIT_V(6); BAR; MMA(1, 1, At, B1); BAR;
  }
  { LDB(B0, 0, 0); LDA(At, 0, 0); STAGE(SA(1, 1), A, lda, brow + HALF, nt - 1);
    BAR; WAIT_L(0); MMA(0, 0, At, B0); BAR;
    LDB(B1, 0, 1); BAR; WAIT_L(0); MMA(0, 1, At, B1); BAR;
    LDA(At, 0, 1); WAIT_V(4); BAR; WAIT_L(0); MMA(1, 0, At, B0); MMA(1, 1, At, B1); BAR; }
  { LDB(B0, 1, 0); LDA(At, 1, 0); WAIT_V(2); BAR; WAIT_L(0); MMA(0, 0, At, B0); BAR;
    LDB(B1, 1, 1); WAIT_V(0); BAR; WAIT_L(0); MMA(0, 1, At, B1); BAR;
    LDA(At, 1, 1); BAR; WAIT_L(0); MMA(1, 0, At, B0); MMA(1, 1, At, B1); BAR; }
  if (wr == 0) BAR;
#undef SA
#undef SB
}

__device__ __forceinline__ void tile_map(int wgid, int nM, int nN, int& pm, int& pn) {
  int nwg = nM * nN;
  int q = nwg / 8, r = nwg % 8, xcd = wgid % 8, off = wgid / 8;
  wgid = (xcd < r ? xcd * (q + 1) : r * (q + 1) + (xcd - r) * q) + off;
  int nig = 8 * nN, gid = wgid / nig, fm = gid * 8, gsz = min(nM - fm, 8);
  pm = fm + ((wgid % nig) % gsz);
  pn = (wgid % nig) / gsz;
}

#define ACC_FOREACH(ai, bj, m, n)                                                                   \
  _Pragma("unroll") for (int ai = 0; ai < 2; ++ai) _Pragma("unroll") for (int bj = 0; bj < 2; ++bj) \
      _Pragma("unroll") for (int m = 0; m < 4; ++m) _Pragma("unroll") for (int n = 0; n < 2; ++n)

__device__ __forceinline__ void phase_inproj(const Params& p, int layer, char* lds, int wave) {
  const u16* A = (const u16*)(p.ws + WS_XB16);
  const u16* Bt = (const u16*)(p.ws + (layer ? WS_WT1 : WS_WT0));
  const float* rs = (const float*)(p.ws + WS_RS);
  const int wr = wave >> 2, wc = wave & 3;
  for (int tile = blockIdx.x; tile < 64 * 64; tile += gridDim.x) {
    int pm, pn;
    tile_map(tile, 64, 64, pm, pn);
    int brow = pm * 256, bcol = pn * 256;
    acc_t acc = {};
    gemm_mainloop(A, DM, Bt, DM, DM, brow, bcol, acc, (u16*)lds, wave);
    const int lane_e = fresh_lane(), fr = lane_e & 15, fq = lane_e >> 4;
    int seg = bcol < 1024 ? 0 : bcol < 2048 ? 1 : bcol < 4096 ? 2 : 3 + (bcol - 4096) / 2048;
    int cbase = seg == 0 ? 0 : seg == 1 ? 1024 : seg == 2 ? 2048 : 4096 + (seg - 3) * 2048;
    int w = seg < 2 ? 1024 : 2048;
    const size_t offs[9] = {WS_Q, WS_K, 0, WS_O, WS_ZA, WS_XBP, WS_ZB, WS_GA, WS_GB};
    size_t off_rm = seg == 0 ? WS_Q : seg == 1 ? WS_K : seg == 3 ? WS_O : seg == 4 ? WS_ZA : seg == 5 ? WS_XBP
                  : seg == 6 ? WS_ZB : seg == 7 ? WS_GA : WS_GB;
    (void)offs;
    u16* dst_rm = (u16*)(p.ws + off_rm) + (bcol - cbase);
    u16* dst_t = (u16*)(p.ws + (seg == 1 ? WS_KT : WS_VT)) + (size_t)(bcol - cbase) * 64;
    const bool do_rm = seg != 2, do_t = (seg == 1 || seg == 2);
#pragma unroll
    for (int ai = 0; ai < 2; ++ai)
#pragma unroll
      for (int m = 0; m < 4; ++m) {
        int row0 = brow + ai * HALF + wr * 64 + m * 16 + fq * 4;
        float r0 = rs[row0], r1 = rs[row0 + 1], r2 = rs[row0 + 2], r3 = rs[row0 + 3];
#pragma unroll
        for (int bj = 0; bj < 2; ++bj)
#pragma unroll
          for (int n = 0; n < 2; ++n) {
            int cl = bj * HALF + wc * 32 + n * 16 + fr;
            f32x4 a = acc[ai][bj][m][n];
            u16 h0 = f2bf(a[0] * r0), h1 = f2bf(a[1] * r1), h2 = f2bf(a[2] * r2), h3 = f2bf(a[3] * r3);
            if (do_t) {
              u16x4 pk = {h0, h1, h2, h3};
              *(u16x4*)(dst_t + ((size_t)(row0 >> 6) * w + cl) * 64 + (row0 & 63)) = pk;
            }
            if (do_rm) {
              u16* d = dst_rm + (size_t)row0 * w + cl;
              d[0] = h0; d[w] = h1; d[2 * w] = h2; d[3 * w] = h3;
            }
            __builtin_amdgcn_sched_barrier(0);
          }
      }
  }
}

__device__ __forceinline__ void phase_branch(const Params& p, int layer, char* lds, int wave) {
  const u16* YA = (const u16*)(p.ws + WS_ZA);
  const u16* YB = (const u16*)(p.ws + WS_ZB);
  const u16* GA = (const u16*)(p.ws + WS_GA);
  const u16* GB = (const u16*)(p.ws + WS_GB);
  const u16* Wa = (const u16*)(p.ws + WS_WSM + (size_t)layer * WSM_STRIDE);
  const u16* Wb = Wa + 4 * MiB;
  u16* MG = (u16*)(p.ws + WS_O);
  const int wr = wave >> 2, wc = wave & 3;
  float* P1 = (float*)(p.ws + WS_Q);
  for (int tile = blockIdx.x; tile < 64 * 8; tile += gridDim.x) {
    int pm, pn;
    tile_map(tile, 64, 8, pm, pn);
    int brow = pm * 256, bcol = pn * 256;
    acc_t acc = {};
    gemm_mainloop(YB, DM, Wb, DM, DM, brow, bcol, acc, (u16*)lds, wave);
    const int lane_e = fresh_lane(), fr = lane_e & 15, fq = lane_e >> 4;
    ACC_FOREACH(ai, bj, m, n) {
      int row0 = brow + ai * HALF + wr * 64 + m * 16 + fq * 4, col = bcol + bj * HALF + wc * 32 + n * 16 + fr;
#pragma unroll
      for (int j = 0; j < 4; ++j) {
        size_t idx = (size_t)(row0 + j) * DM + col;
        P1[idx] = acc[ai][bj][m][n][j] / (1.f + __expf(-bf2f(GB[idx])));
      }
      __builtin_amdgcn_sched_barrier(0);
    }
  }
  for (int tile = blockIdx.x; tile < 64 * 8; tile += gridDim.x) {
    int pm, pn;
    tile_map(tile, 64, 8, pm, pn);
    int brow = pm * 256, bcol = pn * 256;
    acc_t acc = {};
    gemm_mainloop(YA, DM, Wa, DM, DM, brow, bcol, acc, (u16*)lds, wave);
    const int lane_e = fresh_lane(), fr = lane_e & 15, fq = lane_e >> 4;
    ACC_FOREACH(ai, bj, m, n) {
      int row0 = brow + ai * HALF + wr * 64 + m * 16 + fq * 4, col = bcol + bj * HALF + wc * 32 + n * 16 + fr;
#pragma unroll
      for (int j = 0; j < 4; ++j) {
        size_t idx = (size_t)(row0 + j) * DM + col;
        MG[idx] = f2bf(acc[ai][bj][m][n][j] / (1.f + __expf(-bf2f(GA[idx]))) + P1[idx]);
      }
      __builtin_amdgcn_sched_barrier(0);
    }
  }
}

__device__ __forceinline__ void phase_outproj(const Params& p, int layer, char* lds, int wave) {
  const u16* MG = (const u16*)(p.ws + WS_O);
  const u16* Wo = (const u16*)(p.ws + WS_WSM + (size_t)layer * WSM_STRIDE + 16 * MiB);
  const float* xres = layer == 0 ? p.x : p.out;
  const int wr = wave >> 2, wc = wave & 3;
  for (int tile = blockIdx.x; tile < 64 * 8; tile += gridDim.x) {
    int pm, pn;
    tile_map(tile, 64, 8, pm, pn);
    int brow = pm * 256, bcol = pn * 256;
    acc_t acc = {};
    gemm_mainloop(MG, DM, Wo, DM, DM, brow, bcol, acc, (u16*)lds, wave);
    const int lane_e = fresh_lane(), fr = lane_e & 15, fq = lane_e >> 4;
    ACC_FOREACH(ai, bj, m, n) {
      int row0 = brow + ai * HALF + wr * 64 + m * 16 + fq * 4, col = bcol + bj * HALF + wc * 32 + n * 16 + fr;
#pragma unroll
      for (int j = 0; j < 4; ++j) {
        size_t idx = (size_t)(row0 + j) * DM + col;
        p.out[idx] = xres[idx] + acc[ai][bj][m][n][j];
      }
      __builtin_amdgcn_sched_barrier(0);
    }
  }
}

#define MFMA32(a, b, c) __builtin_amdgcn_mfma_f32_32x32x16_bf16(a, b, c, 0, 0, 0)
#define MFMA16(a, b, c) __builtin_amdgcn_mfma_f32_16x16x32_bf16(a, b, c, 0, 0, 0)

__device__ __forceinline__ void mlstm_item(const Params& p, int layer, int grp, int slice, char* lds, int wave) {
  const int b = grp >> 3, hd = (grp >> 1) & 3, dir = grp & 1;
  const int lane = fresh_lane(), tid = wave * 64 + lane, w = wave, r = lane & 31, h = lane >> 5;
  u16* Qs = (u16*)lds;
  u16* Ks = Qs + 64 * 264;
  u16* Kt = Ks + 64 * 264;
  u16* Vt = Kt + 256 * 72;
  u16* Ps = Vt + 64 * 72;
  u16* Cb = Ps + 64 * 72;
  float* vec = (float*)(Cb + 64 * 264);
  float* v_a = vec, *v_c = vec + 64, *v_wi = vec + 128, *v_en = vec + 192, *v_wk = vec + 256, *v_qn = vec + 320,
         *v_den = vec + 384, *v_sc = vec + 448, *v_n = vec + 456;
  float* Xch = (float*)Ks;
  const u16* gq = (const u16*)(p.ws + WS_Q);
  const u16* gk = (const u16*)(p.ws + WS_K);
  const u16* gkt = (const u16*)(p.ws + WS_KT);
  const u16* gvt = (const u16*)(p.ws + WS_VT);
  const float* gates = (const float*)(p.ws + WS_GATES);
  u16* hdst = (u16*)(p.ws + (dir ? WS_WT0 : WS_XB16));

  __syncthreads();
  for (int i = tid; i < 64 * 264; i += 512) Cb[i] = 0;
  if (tid < 256) v_n[tid] = 0.f;
  float m_st = 0.f;
  f32x16 accC[2];
#pragma unroll
  for (int i = 0; i < 16; ++i) { accC[0][i] = 0.f; accC[1][i] = 0.f; }

  for (int st = 0; st < 64; ++st) {
    const int chunk = dir ? 63 - st : st;
    const size_t tok0 = (size_t)b * SEQ + chunk * 64;
    __syncthreads();
#pragma unroll
    for (int i = 0; i < 4; ++i) {
      int idx = tid + 512 * i, row = idx >> 5, c16 = idx & 31;
      *(bf16x8*)(Qs + row * 264 + c16 * 8) = *(const bf16x8*)(gq + (tok0 + row) * 1024 + hd * 256 + c16 * 8);
      *(bf16x8*)(Ks + row * 264 + c16 * 8) = *(const bf16x8*)(gk + (tok0 + row) * 1024 + hd * 256 + c16 * 8);
    }
#pragma unroll
    for (int i = 0; i < 4; ++i) {
      int idx = tid + 512 * i, row = idx >> 3, c16 = idx & 7;
      *(bf16x8*)(Kt + row * 72 + c16 * 8) = *(const bf16x8*)(gkt + ((tok0 >> 6) * 1024 + hd * 256 + row) * 64 + c16 * 8);
    }
    {
      int row = tid >> 3, c16 = tid & 7;
      *(bf16x8*)(Vt + row * 72 + c16 * 8) =
          *(const bf16x8*)(gvt + ((tok0 >> 6) * 2048 + hd * 512 + slice * 64 + row) * 64 + c16 * 8);
    }
    if (w == 0) {
      int L = lane, pos = dir ? 63 - L : L;
      const float* gp = gates + (tok0 + pos) * 16;
      float ipre = gp[dir * 4 + hd], fpre = gp[8 + dir * 4 + hd];
      float lf = fminf(fpre, 0.f) - log1pf(__expf(-fabsf(fpre)));
      float bc = lf;
#pragma unroll
      for (int o = 1; o < 64; o <<= 1) { float t = __shfl_up(bc, o); if (L >= o) bc += t; }
      float a = ipre - bc;
      float cm = a;
#pragma unroll
      for (int o = 1; o < 64; o <<= 1) { float t = __shfl_up(cm, o); if (L >= o) cm = fmaxf(cm, t); }
      float c = fmaxf(m_st, cm);
      float gtot = __shfl(bc, 63), c63 = __shfl(c, 63);
      v_a[pos] = a; v_c[pos] = c; v_wi[pos] = __expf(m_st - c); v_en[pos] = __expf(-(c + bc)); v_wk[pos] = __expf(a - c63);
      if (L == 0) v_sc[0] = __expf(m_st - c63);
      m_st = gtot + c63;
    }
    __syncthreads();
    if (w < 4) {
      int jb = w >> 1, sb = w & 1;
      bool skip = dir ? (sb < jb) : (sb > jb);
      f32x16 sacc;
#pragma unroll
      for (int i = 0; i < 16; ++i) sacc[i] = 0.f;
      if (!skip) {
#pragma unroll 4
        for (int kk = 0; kk < 16; ++kk) {
          bf16x8 af = *(const bf16x8*)(Qs + (jb * 32 + r) * 264 + kk * 16 + h * 8);
          bf16x8 bfr = *(const bf16x8*)(Ks + (sb * 32 + r) * 264 + kk * 16 + h * 8);
          sacc = MFMA32(af, bfr, sacc);
        }
      }
      int s = sb * 32 + r;
      float as_ = v_a[s];
#pragma unroll
      for (int reg = 0; reg < 16; ++reg) {
        int j = jb * 32 + (reg & 3) + 8 * (reg >> 2) + 4 * h;
        bool valid = dir ? (s >= j) : (s <= j);
        float pv = (valid && !skip) ? sacc[reg] * __expf(as_ - v_c[j]) : 0.f;
        Ps[j * 72 + s] = f2bf(pv);
      }
    } else {
      int t2 = tid - 256, j = t2 >> 2, part = t2 & 3;
      float sum = 0.f;
#pragma unroll
      for (int k8 = 0; k8 < 8; ++k8) {
        bf16x8 qv = *(const bf16x8*)(Qs + j * 264 + part * 64 + k8 * 8);
#pragma unroll
        for (int e = 0; e < 8; ++e) sum += bf2f((u16)qv[e]) * v_n[part * 64 + k8 * 8 + e];
      }
      sum += __shfl_xor(sum, 1);
      sum += __shfl_xor(sum, 2);
      if (part == 0) v_qn[j] = sum;
    }
    __syncthreads();
    {
      int t = w & 3, jb = t >> 1, vb = t & 1, kh = w >> 2;
      f32x16 acc;
#pragma unroll
      for (int i = 0; i < 16; ++i) acc[i] = 0.f;
#pragma unroll 4
      for (int kk = kh * 8; kk < kh * 8 + 8; ++kk) {
        bf16x8 af = *(const bf16x8*)(Qs + (jb * 32 + r) * 264 + kk * 16 + h * 8);
        bf16x8 bfr = *(const bf16x8*)(Cb + (vb * 32 + r) * 264 + kk * 16 + h * 8);
        acc = MFMA32(af, bfr, acc);
      }
#pragma unroll
      for (int reg = 0; reg < 16; ++reg) acc[reg] *= v_wi[jb * 32 + (reg & 3) + 8 * (reg >> 2) + 4 * h];
#pragma unroll
      for (int ss = kh * 2; ss < kh * 2 + 2; ++ss) {
        bf16x8 af = *(const bf16x8*)(Ps + (jb * 32 + r) * 72 + ss * 16 + h * 8);
        bf16x8 bfr = *(const bf16x8*)(Vt + (vb * 32 + r) * 72 + ss * 16 + h * 8);
        acc = MFMA32(af, bfr, acc);
      }
      if (kh == 1) {
#pragma unroll
        for (int reg = 0; reg < 16; ++reg) Xch[t * 1024 + reg * 64 + lane] = acc[reg];
        int t2 = tid - 256, j = t2 >> 2, part = t2 & 3;
        float sum = 0.f;
#pragma unroll
        for (int k8 = 0; k8 < 2; ++k8) {
          bf16x8 pv = *(const bf16x8*)(Ps + j * 72 + part * 16 + k8 * 8);
#pragma unroll
          for (int e = 0; e < 8; ++e) sum += bf2f((u16)pv[e]);
        }
        sum += __shfl_xor(sum, 1);
        sum += __shfl_xor(sum, 2);
        if (part == 0) v_den[j] = sum + v_wi[j] * v_qn[j];
      }
      __syncthreads();
      if (kh == 0) {
#pragma unroll
        for (int reg = 0; reg < 16; ++reg) {
          int j = jb * 32 + (reg & 3) + 8 * (reg >> 2) + 4 * h;
          float num = acc[reg] + Xch[t * 1024 + reg * 64 + lane];
          float dn = fmaxf(fabsf(v_den[j]), v_en[j]);
          hdst[(tok0 + j) * DM + hd * 512 + slice * 64 + vb * 32 + r] = f2bf(num / dn);
        }
      }
    }
    {
      int row = tid >> 3, c16 = tid & 7;
      bf16x8 vv = *(const bf16x8*)(Vt + row * 72 + c16 * 8);
#pragma unroll
      for (int e = 0; e < 8; ++e) vv[e] = (short)f2bf(bf2f((u16)vv[e]) * v_wk[c16 * 8 + e]);
      *(bf16x8*)(Vt + row * 72 + c16 * 8) = vv;
      if (tid >= 256) {
        int k = tid - 256;
        float sum = v_sc[0] * v_n[k];
#pragma unroll
        for (int k8 = 0; k8 < 8; ++k8) {
          bf16x8 kv = *(const bf16x8*)(Kt + k * 72 + k8 * 8);
#pragma unroll
          for (int e = 0; e < 8; ++e) sum += bf2f((u16)kv[e]) * v_wk[k8 * 8 + e];
        }
        v_n[k] = sum;
      }
    }
    __syncthreads();
    {
      float decay = v_sc[0];
#pragma unroll
      for (int i = 0; i < 16; ++i) { accC[0][i] *= decay; accC[1][i] *= decay; }
#pragma unroll
      for (int ss = 0; ss < 4; ++ss) {
        bf16x8 af = *(const bf16x8*)(Kt + (32 * w + r) * 72 + ss * 16 + h * 8);
        bf16x8 b0 = *(const bf16x8*)(Vt + (r) * 72 + ss * 16 + h * 8);
        bf16x8 b1 = *(const bf16x8*)(Vt + (32 + r) * 72 + ss * 16 + h * 8);
        accC[0] = MFMA32(af, b0, accC[0]);
        accC[1] = MFMA32(af, b1, accC[1]);
      }
#pragma unroll
      for (int vb = 0; vb < 2; ++vb)
#pragma unroll
        for (int g = 0; g < 4; ++g) {
          u16x4 pk = {f2bf(accC[vb][4 * g]), f2bf(accC[vb][4 * g + 1]), f2bf(accC[vb][4 * g + 2]), f2bf(accC[vb][4 * g + 3])};
          *(u16x4*)(Cb + (vb * 32 + r) * 264 + 32 * w + 8 * g + 4 * h) = pk;
        }
    }
  }
  __syncthreads();
}

template <int dir>
__device__ __forceinline__ void lru_item(const Params& p, int layer, int item, char* lds, int wave) {
  const int b = item >> 6, blk = (item >> 2) & 15, half = item & 1;
  const int lane = fresh_lane(), tid = wave * 64 + lane, w = wave, c = lane & 15, q = lane >> 4;
  u16* xcb = (u16*)lds;
  float* xcf = (float*)(lds + 64 * 136 * 2);
  const u16* xbp = (const u16*)(p.ws + WS_XBP);
  u16* hdst = (u16*)(p.ws + (dir ? WS_LHB : WS_LHF));
  const int cg = tid & 15, tt0 = tid >> 4;
  float cw[4][8], cbias[8];
#pragma unroll
  for (int e = 0; e < 8; ++e) {
    int ch = blk * 128 + cg * 8 + e;
    cbias[e] = p.conv_b[layer * DM + ch];
#pragma unroll
    for (int tap = 0; tap < 4; ++tap) cw[tap][e] = p.conv_w[(layer * 4 + tap) * DM + ch];
  }
  bf16x8 Br[4], Bi[4];
  float br = 0.f, bi = 0.f, sp = 0.f;
  const int chl = half * 64 + 16 * (w & 3) + c, ch = blk * 128 + chl;
  if (w < 4) {
    const u16* wrg = (const u16*)(p.ws + WS_WSM + (size_t)layer * WSM_STRIDE + 24 * MiB);
    const u16* wr_ = wrg + ((size_t)((dir * 2 + 0) * 16 + blk)) * 16384 + chl * 128;
    const u16* wi_ = wrg + ((size_t)((dir * 2 + 1) * 16 + blk)) * 16384 + chl * 128;
#pragma unroll
    for (int kk = 0; kk < 4; ++kk) {
      Br[kk] = *(const bf16x8*)(wr_ + kk * 32 + q * 8);
      Bi[kk] = *(const bf16x8*)(wi_ + kk * 32 + q * 8);
    }
    br = p.b_rg[((layer * 2 + dir) * 2 + 0) * DM + ch];
    bi = p.b_rg[((layer * 2 + dir) * 2 + 1) * DM + ch];
    float lam = p.lam[(layer * 2 + dir) * DM + ch];
    sp = fmaxf(-lam, 0.f) + log1pf(__expf(-fabsf(lam)));
  }
  float carry = 0.f;
  for (int ti = 0; ti < 64; ++ti) {
    const int tile = dir ? 63 - ti : ti, s0 = tile * 64;
    __syncthreads();
#pragma unroll
    for (int pass = 0; pass < 2; ++pass) {
      int tt = tt0 + 32 * pass, s = s0 + tt;
      float xc[8];
#pragma unroll
      for (int e = 0; e < 8; ++e) xc[e] = cbias[e];
#pragma unroll
      for (int tap = 0; tap < 4; ++tap) {
        int sp_ = s + tap - 2;
        if (sp_ >= 0 && sp_ < SEQ) {
          bf16x8 xv = *(const bf16x8*)(xbp + ((size_t)b * SEQ + sp_) * DM + blk * 128 + cg * 8);
#pragma unroll
          for (int e = 0; e < 8; ++e) xc[e] += cw[tap][e] * bf2f((u16)xv[e]);
        }
      }
      bf16x8 o8;
#pragma unroll
      for (int e = 0; e < 8; ++e) o8[e] = (short)f2bf(xc[e]);
      *(bf16x8*)(xcb + tt * 136 + cg * 8) = o8;
      if ((cg >> 3) == half) {
        float* d = xcf + tt * 68 + (cg & 7) * 8;
        *(float4*)d = make_float4(xc[0], xc[1], xc[2], xc[3]);
        *(float4*)(d + 4) = make_float4(xc[4], xc[5], xc[6], xc[7]);
      }
    }
    __syncthreads();
    if (w < 4) {
      f32x4 ar[4], ai_[4];
#pragma unroll
      for (int m = 0; m < 4; ++m) {
        ar[m] = f32x4{0.f, 0.f, 0.f, 0.f};
        ai_[m] = f32x4{0.f, 0.f, 0.f, 0.f};
#pragma unroll
        for (int kk = 0; kk < 4; ++kk) {
          bf16x8 af = *(const bf16x8*)(xcb + (16 * m + c) * 136 + kk * 32 + q * 8);
          ar[m] = MFMA16(af, Br[kk], ar[m]);
          ai_[m] = MFMA16(af, Bi[kk], ai_[m]);
        }
      }
#pragma unroll
      for (int mi = 0; mi < 4; ++mi) {
        const int m = dir ? 3 - mi : mi;
        float a_[4], u_[4];
#pragma unroll
        for (int i = 0; i < 4; ++i) {
          float rg = sigmoidf_(ar[m][i] + br), ig = sigmoidf_(ai_[m][i] + bi);
          float la = -8.f * sp * rg;
          float a = __expf(la);
          float xv = xcf[(16 * m + 4 * q + i) * 68 + 16 * w + c];
          a_[i] = a;
          u_[i] = sqrtf(fmaxf(1.f - a * a, 0.f)) * ig * xv;
        }
        float A4 = a_[0] * a_[1] * a_[2] * a_[3];
        float hv[4];
        if (!dir) {
          float U4 = ((u_[0] * a_[1] + u_[1]) * a_[2] + u_[2]) * a_[3] + u_[3];
          float hin = carry;
#pragma unroll
          for (int qq = 0; qq < 3; ++qq) {
            float Aq = __shfl(A4, qq * 16 + c), Uq = __shfl(U4, qq * 16 + c);
            if (qq < q) hin = Aq * hin + Uq;
          }
          hv[0] = a_[0] * hin + u_[0];
          hv[1] = a_[1] * hv[0] + u_[1];
          hv[2] = a_[2] * hv[1] + u_[2];
          hv[3] = a_[3] * hv[2] + u_[3];
          carry = __shfl(hv[3], 48 + c);
        } else {
          float U4 = ((u_[3] * a_[2] + u_[2]) * a_[1] + u_[1]) * a_[0] + u_[0];
          float hin = carry;
#pragma unroll
          for (int qq = 3; qq > 0; --qq) {
            float Aq = __shfl(A4, qq * 16 + c), Uq = __shfl(U4, qq * 16 + c);
            if (qq > q) hin = Aq * hin + Uq;
          }
          hv[3] = a_[3] * hin + u_[3];
          hv[2] = a_[2] * hv[3] + u_[2];
          hv[1] = a_[1] * hv[2] + u_[1];
          hv[0] = a_[0] * hv[1] + u_[0];
          carry = __shfl(hv[0], c);
        }
#pragma unroll
        for (int i = 0; i < 4; ++i)
          hdst[((size_t)b * SEQ + s0 + 16 * m + 4 * q + i) * DM + ch] = f2bf(hv[i]);
      }
    }
  }
  __syncthreads();
}

__device__ __forceinline__ void phase_mixers(const Params& p, int layer, char* lds, int wave) {
  for (int it = blockIdx.x; it < 512; it += gridDim.x) {
    if (it < 256) {
      int j = it >> 3;
      mlstm_item(p, layer, (it & 7) * 4 + (j >> 3), j & 7, lds, wave);
    } else {
      if (((it - 256) >> 1) & 1) lru_item<1>(p, layer, it - 256, lds, wave);
      else lru_item<0>(p, layer, it - 256, lds, wave);
    }
  }
}

__device__ __forceinline__ void phase_post(const Params& p, int layer, int wave) {
  int lane = fresh_lane(), wid = wave;
  int gw = blockIdx.x * 8 + wid, nw = gridDim.x * 8;
  const u16* hf = (const u16*)(p.ws + WS_XB16);
  const u16* hb = (const u16*)(p.ws + WS_WT0);
  const u16* lf = (const u16*)(p.ws + WS_LHF);
  const u16* lb = (const u16*)(p.ws + WS_LHB);
  const u16* o = (const u16*)(p.ws + WS_O);
  u16* za = (u16*)(p.ws + WS_ZA);
  u16* zb = (u16*)(p.ws + WS_ZB);
  for (int wi = gw; wi < T * 4; wi += nw) {
    size_t off = (size_t)(wi >> 2) * DM + (wi & 3) * 512 + lane * 8;
    int col = (wi & 3) * 512 + lane * 8;
    bf16x8 f8 = *(const bf16x8*)(hf + off), b8 = *(const bf16x8*)(hb + off);
    bf16x8 o8 = *(const bf16x8*)(o + off), z8 = *(const bf16x8*)(za + off);
    bf16x8 lf8 = *(const bf16x8*)(lf + off), lb8 = *(const bf16x8*)(lb + off), zb8 = *(const bf16x8*)(zb + off);
    float hv[8], ss = 0.f;
#pragma unroll
    for (int e = 0; e < 8; ++e) { hv[e] = bf2f((u16)f8[e]) + bf2f((u16)b8[e]); ss += hv[e] * hv[e]; }
#pragma unroll
    for (int s = 32; s >= 1; s >>= 1) ss += __shfl_xor(ss, s);
    float rn = rsqrtf(ss * (1.f / 512.f) + EPS);
    const float* hg = p.head_g + layer * DM + col;
    bf16x8 ya, yb;
#pragma unroll
    for (int e = 0; e < 8; ++e) {
      float ov = bf2f((u16)o8[e]), zv = bf2f((u16)z8[e]);
      float y = hv[e] * rn * hg[e] * sigmoidf_(ov) * (zv * sigmoidf_(zv));
      ya[e] = (short)f2bf(y);
      float zbv = bf2f((u16)zb8[e]);
      float y2 = (bf2f((u16)lf8[e]) + bf2f((u16)lb8[e])) * (zbv * sigmoidf_(zbv));
      yb[e] = (short)f2bf(y2);
    }
    *(bf16x8*)(za + off) = ya;
    *(bf16x8*)(zb + off) = yb;
  }
}

constexpr int NPHASE = 13;
#define PH(n, code)                         \
  if (ph_lo <= (n) && (n) < ph_hi) {        \
    if ((n) > ph_lo) cg::this_grid().sync(); \
    code;                                   \
  }
__global__ void __launch_bounds__(512, 2) mega(Params p, int ph_lo, int ph_hi) {
  extern __shared__ __attribute__((aligned(16))) char lds[];
  const int wave = __builtin_amdgcn_readfirstlane(threadIdx.x >> 6);
  PH(0, { phase_convert(p, lds, wave); phase_rowpass(p, 0, p.x, wave); })
  PH(1, phase_inproj(p, 0, lds, wave))
  PH(2, phase_mixers(p, 0, lds, wave))
  PH(3, phase_post(p, 0, wave))
  PH(4, phase_branch(p, 0, lds, wave))
  PH(5, phase_outproj(p, 0, lds, wave))
  PH(6, phase_rowpass(p, 1, p.out, wave))
  PH(7, phase_inproj(p, 1, lds, wave))
  PH(8, phase_mixers(p, 1, lds, wave))
  PH(9, phase_post(p, 1, wave))
  PH(10, phase_branch(p, 1, lds, wave))
  PH(11, phase_outproj(p, 1, lds, wave))
  PH(12, phase_final(p, wave))
}

extern "C" void kernel_launch(void* const* d_in, const int* in_sizes, int n_in, void* d_out, int out_size, void* d_ws,
                              size_t ws_size, hipStream_t stream) {
  static int grid = 0;
  if (grid == 0) {
    if (ws_size < WS_END) { fprintf(stderr, "workspace too small: %zu < %zu\n", ws_size, (size_t)WS_END); grid = -1; return; }
    int dev = 0, cus = 0, per_cu = 0;
    hipGetDevice(&dev);
    hipDeviceGetAttribute(&cus, hipDeviceAttributeMultiprocessorCount, dev);
    if (hipFuncSetAttribute((const void*)mega, hipFuncAttributeMaxDynamicSharedMemorySize, LDS_BYTES) != hipSuccess) {
      fprintf(stderr, "hipFuncSetAttribute failed\n"); grid = -1; return;
    }
    hipOccupancyMaxActiveBlocksPerMultiprocessor(&per_cu, (const void*)mega, 512, LDS_BYTES);
    if (per_cu < 1) { fprintf(stderr, "occupancy query says %d\n", per_cu); per_cu = 1; }
    (void)hipGetLastError();
    grid = cus * 1;
  }
  if (grid < 0) return;
  Params p{};
  p.x = (const float*)d_in[0]; p.norm_g = (const float*)d_in[1]; p.w_in = (const float*)d_in[2];
  p.b_if = (const float*)d_in[3]; p.head_g = (const float*)d_in[4]; p.conv_w = (const float*)d_in[5];
  p.conv_b = (const float*)d_in[6]; p.w_rg = (const float*)d_in[7]; p.b_rg = (const float*)d_in[8];
  p.lam = (const float*)d_in[9]; p.w_a = (const float*)d_in[10]; p.w_b = (const float*)d_in[11];
  p.w_o = (const float*)d_in[12]; p.final_g = (const float*)d_in[13];
  p.out = (float*)d_out; p.ws = (unsigned char*)d_ws;
#if COOP
  int lo = 0, hi = NPHASE;
  void* args[] = {&p, &lo, &hi};
  hipError_t e = hipLaunchCooperativeKernel((const void*)mega, dim3(grid), dim3(512), args, LDS_BYTES, stream);
  if (e != hipSuccess) fprintf(stderr, "cooperative launch failed: %s (grid %d)\n", hipGetErrorString(e), grid);
#else
  for (int ph = 0; ph < NPHASE; ++ph) hipLaunchKernelGGL(mega, dim3(grid), dim3(512), LDS_BYTES, stream, p, ph, ph + 1);
#endif
}
```

```cpp
#include <hip/hip_runtime.h>
#include <hip/hip_cooperative_groups.h>
#include <cstdio>
#include <cstdint>
namespace cg = cooperative_groups;

#ifndef COOP
#define COOP 1
#endif

typedef unsigned short u16;
using bf16x8 = __attribute__((ext_vector_type(8))) short;
using u16x4 = __attribute__((ext_vector_type(4))) unsigned short;
using f32x4 = __attribute__((ext_vector_type(4))) float;
using f32x16 = __attribute__((ext_vector_type(16))) float;

constexpr int T = 16384, SEQ = 4096, DM = 2048, NIN = 16400;
constexpr float EPS = 1e-6f;
constexpr size_t MiB = 1ull << 20;
constexpr size_t WS_WT0 = 0;
constexpr size_t WS_WT1 = 64 * MiB;
constexpr size_t WS_WSM = 128 * MiB;
constexpr size_t WSM_STRIDE = 27 * MiB;
constexpr size_t WS_Q = 182 * MiB, WS_K = 214 * MiB, WS_KT = 246 * MiB, WS_VT = 278 * MiB, WS_O = 342 * MiB,
                 WS_ZA = 406 * MiB, WS_XBP = 470 * MiB, WS_ZB = 534 * MiB, WS_GA = 598 * MiB, WS_GB = 662 * MiB,
                 WS_XB16 = 726 * MiB,
                 WS_LHF = 790 * MiB, WS_LHB = 854 * MiB, WS_RS = 918 * MiB, WS_GATES = 918 * MiB + 65536,
                 WS_END = 920 * MiB;
constexpr int LDS_BYTES = 160 * 1024;

struct Params {
  const float *x, *norm_g, *w_in, *b_if, *head_g, *conv_w, *conv_b, *w_rg, *b_rg, *lam, *w_a, *w_b, *w_o, *final_g;
  float* out;
  unsigned char* ws;
};

__device__ __forceinline__ u16 f2bf(float f) {
  uint32_t u = __float_as_uint(f);
  u += 0x7fffu + ((u >> 16) & 1u);
  return (u16)(u >> 16);
}
__device__ __forceinline__ float bf2f(u16 h) { return __uint_as_float(((uint32_t)h) << 16); }
__device__ __forceinline__ int fresh_lane() {
  int l;
  asm volatile("v_mbcnt_lo_u32_b32 %0, -1, 0\n\tv_mbcnt_hi_u32_b32 %0, -1, %0" : "=v"(l));
  return l & 63;
}
#define TID_DECL const int tid = wave * 64 + fresh_lane()
__device__ __forceinline__ float sigmoidf_(float x) { return 1.f / (1.f + __expf(-x)); }

__device__ __forceinline__ void tconv_tile(const float* __restrict__ src, long ld_src, int k0, int n0s, u16* __restrict__ dst,
                           long ld_dst, int n0d, const float* __restrict__ rowscale, float cs, float* tile, int wave) {
  TID_DECL;
  int c = tid & 63, r = tid >> 6;
#pragma unroll
  for (int i = 0; i < 8; ++i) {
    int kl = r + 8 * i;
    float v = src[(long)(k0 + kl) * ld_src + n0s + c];
    if (rowscale) v *= rowscale[k0 + kl];
    tile[kl * 65 + c] = v * cs;
  }
  __syncthreads();
#pragma unroll
  for (int i = 0; i < 8; ++i) {
    int nl = r + 8 * i;
    dst[(long)(n0d + nl) * ld_dst + k0 + c] = f2bf(tile[c * 65 + nl]);
  }
  __syncthreads();
}

__device__ __forceinline__ void phase_convert(const Params& p, char* lds, int wave) {
  TID_DECL;
  float* tile = (float*)lds;
  constexpr int PER_LAYER = 8192 + 3072 + 256 + 1;
  for (int it = blockIdx.x; it < 2 * PER_LAYER; it += gridDim.x) {
    int l = it / PER_LAYER, r = it % PER_LAYER;
    unsigned char* wsm = p.ws + WS_WSM + (size_t)l * WSM_STRIDE;
    if (r < 8192) {
      int kt = r & 31, nt = r >> 5;
      int n0d = nt * 64, n0s = n0d < 8192 ? n0d : n0d + 16;
      float cs = (n0d >= 1024 && n0d < 2048) ? 0.0625f : 1.f;
      u16* dst = (u16*)(p.ws + (l ? WS_WT1 : WS_WT0));
      tconv_tile(p.w_in + (size_t)l * DM * NIN, NIN, kt * 64, n0s, dst, DM, n0d, p.norm_g + l * DM, cs, tile, wave);
    } else if (r < 8192 + 3072) {
      int q = r - 8192, which = q >> 10, tt = q & 1023, kt = tt & 31, nt = tt >> 5;
      const float* src = (which == 0 ? p.w_a : which == 1 ? p.w_b : p.w_o) + (size_t)l * DM * DM;
      u16* dst = (u16*)(wsm + (size_t)which * 8 * MiB);
      tconv_tile(src, DM, kt * 64, nt * 64, dst, DM, nt * 64, nullptr, 1.f, tile, wave);
    } else if (r < 8192 + 3072 + 256) {
      int q = r - 8192 - 3072, mat = q >> 2, tt = q & 3;
      const float* src = p.w_rg + ((size_t)l * 64 + mat) * 16384;
      u16* dst = (u16*)(wsm + 24 * MiB) + (size_t)mat * 16384;
      tconv_tile(src, 128, (tt & 1) * 64, (tt >> 1) * 64, dst, 128, (tt >> 1) * 64, nullptr, 1.f, tile, wave);
    } else {
      u16* dst = (u16*)(wsm + 26 * MiB);
      const float* src = p.w_in + (size_t)l * DM * NIN;
      for (int i = tid; i < 16 * DM; i += 512) {
        int j = i >> 11, k = i & 2047;
        dst[i] = f2bf(src[(size_t)k * NIN + 8192 + j] * p.norm_g[l * DM + k]);
      }
    }
  }
}

__device__ __forceinline__ void phase_rowpass(const Params& p, int layer, const float* __restrict__ xin, int wave) {
  int lane = fresh_lane(), wid = wave;
  int gw = blockIdx.x * 8 + wid, nw = gridDim.x * 8;
  int r = lane & 15, q = lane >> 4;
  u16* xb16 = (u16*)(p.ws + WS_XB16);
  float* rs = (float*)(p.ws + WS_RS);
  float* gates = (float*)(p.ws + WS_GATES);
  const u16* wg = (const u16*)(p.ws + WS_WSM + (size_t)layer * WSM_STRIDE + 26 * MiB);
  for (int rt = gw; rt < T / 16; rt += nw) {
    int row = rt * 16 + r;
    const float* xr = xin + (size_t)row * DM + q * 8;
    f32x4 acc = {0.f, 0.f, 0.f, 0.f};
    float ss = 0.f;
#pragma unroll 4
    for (int kk = 0; kk < 64; ++kk) {
      float4 a0 = *(const float4*)(xr + kk * 32);
      float4 a1 = *(const float4*)(xr + kk * 32 + 4);
      ss += a0.x * a0.x + a0.y * a0.y + a0.z * a0.z + a0.w * a0.w + a1.x * a1.x + a1.y * a1.y + a1.z * a1.z + a1.w * a1.w;
      bf16x8 af;
      af[0] = (short)f2bf(a0.x); af[1] = (short)f2bf(a0.y); af[2] = (short)f2bf(a0.z); af[3] = (short)f2bf(a0.w);
      af[4] = (short)f2bf(a1.x); af[5] = (short)f2bf(a1.y); af[6] = (short)f2bf(a1.z); af[7] = (short)f2bf(a1.w);
      *(bf16x8*)(xb16 + (size_t)row * DM + kk * 32 + q * 8) = af;
      bf16x8 bfr = *(const bf16x8*)(wg + (size_t)r * DM + kk * 32 + q * 8);
      acc = __builtin_amdgcn_mfma_f32_16x16x32_bf16(af, bfr, acc, 0, 0, 0);
    }
    ss += __shfl_xor(ss, 16);
    ss += __shfl_xor(ss, 32);
    float rsv = rsqrtf(ss * (1.f / DM) + EPS);
    if (q == 0) rs[row] = rsv;
    float bias = p.b_if[layer * 16 + r];
#pragma unroll
    for (int j = 0; j < 4; ++j) {
      float rr = __shfl(rsv, q * 4 + j);
      gates[(size_t)(rt * 16 + q * 4 + j) * 16 + r] = acc[j] * rr + bias;
    }
  }
}

__device__ __forceinline__ void phase_final(const Params& p, int wave) {
  int lane = fresh_lane(), wid = wave;
  int gw = blockIdx.x * 8 + wid, nw = gridDim.x * 8;
  for (int row = gw; row < T; row += nw) {
    float* xr = p.out + (size_t)row * DM;
    float4 v[8];
    float ss = 0.f;
#pragma unroll
    for (int i = 0; i < 8; ++i) {
      v[i] = *(const float4*)(xr + i * 256 + lane * 4);
      ss += v[i].x * v[i].x + v[i].y * v[i].y + v[i].z * v[i].z + v[i].w * v[i].w;
    }
#pragma unroll
    for (int o = 32; o >= 1; o >>= 1) ss += __shfl_xor(ss, o);
    float rsv = rsqrtf(ss * (1.f / DM) + EPS);
#pragma unroll
    for (int i = 0; i < 8; ++i) {
      float4 g = *(const float4*)(p.final_g + i * 256 + lane * 4);
      float4 o4;
      o4.x = v[i].x * rsv * g.x; o4.y = v[i].y * rsv * g.y; o4.z = v[i].z * rsv * g.z; o4.w = v[i].w * rsv * g.w;
      *(float4*)(xr + i * 256 + lane * 4) = o4;
    }
  }
}

constexpr int BM = 256, BK = 64, HALF = 128, HT = HALF * BK;
__device__ __forceinline__ int lds_byte(int r, int c) {
  int st = (r >> 4) * 2 + (c >> 5), rr = r & 15, cc = c & 31, ob = rr * 64 + cc * 2;
  return st * 1024 + (ob ^ (((ob >> 9) & 1) << 5));
}
__device__ __forceinline__ void stage_rc(int b, int& R, int& C) {
  int st = b / 1024, sb = b % 1024, swz = sb ^ (((sb >> 9) & 1) << 5);
  R = (st >> 1) * 16 + swz / 64;
  C = (st & 1) * 32 + (swz % 64) / 2;
}

typedef f32x4 acc_t[2][2][4][2];

__device__ __forceinline__ void gemm_mainloop(const u16* __restrict__ A, long lda, const u16* __restrict__ Bt, long ldb,
                                              int K, int brow, int bcol, acc_t& acc, u16* shm, int wave) {
#define SA(b, h) (shm + ((b) * 2 + (h)) * HT)
#define SB(b, h) (shm + (4 + (b) * 2 + (h)) * HT)
#define STAGE(P, BASE, LD, br, kt)                                                                             \
  do {                                                                                                         \
    const u16* _gb = (BASE) + ((size_t)(br) * 2048 + (size_t)(kt) * BK);                                       \
    __builtin_amdgcn_global_load_lds((const unsigned*)(_gb + soff0), (unsigned*)((char*)(P) + tid * 16), 16, 0, 0);        \
    __builtin_amdgcn_global_load_lds((const unsigned*)(_gb + soff1), (unsigned*)((char*)(P) + tid * 16 + 8192), 16, 0, 0); \
  } while (0)
#define LDA(dst, b, h)                                                                                         \
  _Pragma("unroll") for (int m = 0; m < 4; ++m)                                                                \
    _Pragma("unroll") for (int k = 0; k < 2; ++k)                                                              \
  dst[m][k] = *reinterpret_cast<const bf16x8*>((char*)SA(b, h) + lds_byte(wr * 64 + m * 16 + fr, k * 32 + fq * 8))
#define LDB(dst, b, h)                                                                                         \
  _Pragma("unroll") for (int n = 0; n < 2; ++n)                                                                \
    _Pragma("unroll") for (int k = 0; k < 2; ++k)                                                              \
  dst[n][k] = *reinterpret_cast<const bf16x8*>((char*)SB(b, h) + lds_byte(wc * 32 + n * 16 + fr, k * 32 + fq * 8))
#define MMA(ai, bj, At, Bt_)                                                                                   \
  do {                                                                                                         \
    __builtin_amdgcn_s_setprio(1);                                                                             \
    _Pragma("unroll") for (int m = 0; m < 4; ++m)                                                              \
      _Pragma("unroll") for (int n = 0; n < 2; ++n)                                                            \
        _Pragma("unroll") for (int k = 0; k < 2; ++k)                                                          \
          acc[ai][bj][m][n] = __builtin_amdgcn_mfma_f32_16x16x32_bf16(At[m][k], Bt_[n][k], acc[ai][bj][m][n], 0, 0, 0); \
    __builtin_amdgcn_s_setprio(0);                                                                             \
  } while (0)
#define WAIT_V(n) asm volatile("s_waitcnt vmcnt(" #n ")" ::: "memory")
#define WAIT_L(n) asm volatile("s_waitcnt lgkmcnt(" #n ")" ::: "memory")
#define BAR __builtin_amdgcn_s_barrier()
#define SCHED __builtin_amdgcn_sched_barrier(0)
  const int lane = fresh_lane(), tid = wave * 64 + lane;
  int wid = wave, wr = wid >> 2, wc = wid & 3, fr = lane & 15, fq = lane >> 4;
  bf16x8 At[4][2], B0[2][2], B1[2][2];
  int nt = K / BK;
  unsigned soff0, soff1;
  { int _r, _c; stage_rc(tid * 16, _r, _c); soff0 = _r * 2048 + _c; stage_rc(tid * 16 + 8192, _r, _c); soff1 = _r * 2048 + _c; }
  STAGE(SB(0, 0), Bt, ldb, bcol, 0); STAGE(SA(0, 0), A, lda, brow, 0);
  STAGE(SB(0, 1), Bt, ldb, bcol + HALF, 0); STAGE(SA(0, 1), A, lda, brow + HALF, 0);
  if (wr == 1) BAR;
  WAIT_V(4); BAR;
  STAGE(SB(1, 0), Bt, ldb, bcol, 1); STAGE(SA(1, 0), A, lda, brow, 1); STAGE(SB(1, 1), Bt, ldb, bcol + HALF, 1);
  WAIT_V(6); BAR;
  for (int t = 0; t < nt - 2; t += 2) {
    LDB(B0, 0, 0); SCHED; LDA(At, 0, 0); STAGE(SA(1, 1), A, lda, brow + HALF, t + 1);
    WAIT_L(8); BAR; WAIT_L(0); MMA(0, 0, At, B0); BAR; SCHED;
    LDB(B1, 0, 1); STAGE(SB(0, 0), Bt, ldb, bcol, t + 2);
    BAR; WAIT_L(0); MMA(0, 1, At, B1); BAR;
    LDA(At, 0, 1); STAGE(SA(0, 0), A, lda, brow, t + 2);
    BAR; WAIT_L(0); MMA(1, 0, At, B0); BAR; SCHED;
    STAGE(SB(0, 1), Bt, ldb, bcol + HALF, t + 2);
    WAIT_V(6); BAR; MMA(1, 1, At, B1); BAR;
    LDB(B0, 1, 0); SCHED; LDA(At, 1, 0); STAGE(SA(0, 1), A, lda, brow + HALF, t + 2);
    WAIT_L(8); BAR; WAIT_L(0); MMA(0, 0, At, B0); BAR; SCHED;
    LDB(B1, 1, 1); STAGE(SB(1, 0), Bt, ldb, bcol, t + 3);
    BAR; WAIT_L(0); MMA(0, 1, At, B1); BAR;
    LDA(At, 1, 1); STAGE(SA(1, 0), A, lda, brow, t + 3);
    BAR; WAIT_L(0); MMA(1, 0, At, B0); BAR; SCHED;
    STAGE(SB(1, 1), Bt, ldb, bcol + HALF, t + 3);
    WAIT_V(6); BAR; MMA(1, 1, At, B1); BAR;
  }
  { LDB(B0, 0, 0); LDA(At, 0, 0); STAGE(SA(1, 1), A, lda, brow + HALF, nt - 1);
    BAR; WAIT_L(0); MMA(0, 0, At, B0); BAR;
    LDB(B1, 0, 1); BAR; WAIT_L(0); MMA(0, 1, At, B1); BAR;
    LDA(At, 0, 1); WAIT_V(4); BAR; WAIT_L(0); MMA(1, 0, At, B0); MMA(1, 1, At, B1); BAR; }
  { LDB(B0, 1, 0); LDA(At, 1, 0); WAIT_V(2); BAR; WAIT_L(0); MMA(0, 0, At, B0); BAR;
    LDB(B1, 1, 1); WAIT_V(0); BAR; WAIT_L(0); MMA(0, 1, At, B1); BAR;
    LDA(At, 1, 1); BAR; WAIT_L(0); MMA(1, 0, At, B0); MMA(1, 1, At, B1); BAR; }
  if (wr == 0) BAR;
#undef SA
#undef SB
}

__device__ __forceinline__ void tile_map(int wgid, int nM, int nN, int& pm, int& pn) {
  int nwg = nM * nN;
  int q = nwg / 8, r = nwg % 8, xcd = wgid % 8, off = wgid / 8;
  wgid = (xcd < r ? xcd * (q + 1) : r * (q + 1) + (xcd - r) * q) + off;
  int nig = 8 * nN, gid = wgid / nig, fm = gid * 8, gsz = min(nM - fm, 8);
  pm = fm + ((wgid % nig) % gsz);
  pn = (wgid % nig) / gsz;
}

#define ACC_FOREACH(ai, bj, m, n)                                                                   \
  _Pragma("unroll") for (int ai = 0; ai < 2; ++ai) _Pragma("unroll") for (int bj = 0; bj < 2; ++bj) \
      _Pragma("unroll") for (int m = 0; m < 4; ++m) _Pragma("unroll") for (int n = 0; n < 2; ++n)

__device__ __forceinline__ void phase_inproj(const Params& p, int layer, char* lds, int wave) {
  const u16* A = (const u16*)(p.ws + WS_XB16);
  const u16* Bt = (const u16*)(p.ws + (layer ? WS_WT1 : WS_WT0));
  const float* rs = (const float*)(p.ws + WS_RS);
  const int wr = wave >> 2, wc = wave & 3;
  for (int tile = blockIdx.x; tile < 64 * 64; tile += gridDim.x) {
    int pm, pn;
    tile_map(tile, 64, 64, pm, pn);
    int brow = pm * 256, bcol = pn * 256;
    acc_t acc = {};
    gemm_mainloop(A, DM, Bt, DM, DM, brow, bcol, acc, (u16*)lds, wave);
    const int lane_e = fresh_lane(), fr = lane_e & 15, fq = lane_e >> 4;
    int seg = bcol < 1024 ? 0 : bcol < 2048 ? 1 : bcol < 4096 ? 2 : 3 + (bcol - 4096) / 2048;
    int cbase = seg == 0 ? 0 : seg == 1 ? 1024 : seg == 2 ? 2048 : 4096 + (seg - 3) * 2048;
    int w = seg < 2 ? 1024 : 2048;
    const size_t offs[9] = {WS_Q, WS_K, 0, WS_O, WS_ZA, WS_XBP, WS_ZB, WS_GA, WS_GB};
    size_t off_rm = seg == 0 ? WS_Q : seg == 1 ? WS_K : seg == 3 ? WS_O : seg == 4 ? WS_ZA : seg == 5 ? WS_XBP
                  : seg == 6 ? WS_ZB : seg == 7 ? WS_GA : WS_GB;
    (void)offs;
    u16* dst_rm = (u16*)(p.ws + off_rm) + (bcol - cbase);
    u16* dst_t = (u16*)(p.ws + (seg == 1 ? WS_KT : WS_VT)) + (size_t)(bcol - cbase) * 64;
    const bool do_rm = seg != 2, do_t = (seg == 1 || seg == 2);
#pragma unroll
    for (int ai = 0; ai < 2; ++ai)
#pragma unroll
      for (int m = 0; m < 4; ++m) {
        int row0 = brow + ai * HALF + wr * 64 + m * 16 + fq * 4;
        float r0 = rs[row0], r1 = rs[row0 + 1], r2 = rs[row0 + 2], r3 = rs[row0 + 3];
#pragma unroll
        for (int bj = 0; bj < 2; ++bj)
#pragma unroll
          for (int n = 0; n < 2; ++n) {
            int cl = bj * HALF + wc * 32 + n * 16 + fr;
            f32x4 a = acc[ai][bj][m][n];
            u16 h0 = f2bf(a[0] * r0), h1 = f2bf(a[1] * r1), h2 = f2bf(a[2] * r2), h3 = f2bf(a[3] * r3);
            if (do_t) {
              u16x4 pk = {h0, h1, h2, h3};
              *(u16x4*)(dst_t + ((size_t)(row0 >> 6) * w + cl) * 64 + (row0 & 63)) = pk;
            }
            if (do_rm) {
              u16* d = dst_rm + (size_t)row0 * w + cl;
              d[0] = h0; d[w] = h1; d[2 * w] = h2; d[3 * w] = h3;
            }
            __builtin_amdgcn_sched_barrier(0);
          }
      }
  }
}

__device__ __forceinline__ void phase_branch(const Params& p, int layer, char* lds, int wave) {
  const u16* YA = (const u16*)(p.ws + WS_ZA);
  const u16* YB = (const u16*)(p.ws + WS_ZB);
  const u16* GA = (const u16*)(p.ws + WS_GA);
  const u16* GB = (const u16*)(p.ws + WS_GB);
  const u16* Wa = (const u16*)(p.ws + WS_WSM + (size_t)layer * WSM_STRIDE);
  const u16* Wb = Wa + 4 * MiB;
  u16* MG = (u16*)(p.ws + WS_O);
  const int wr = wave >> 2, wc = wave & 3;
  float* P1 = (float*)(p.ws + WS_Q);
  for (int tile = blockIdx.x; tile < 64 * 8; tile += gridDim.x) {
    int pm, pn;
    tile_map(tile, 64, 8, pm, pn);
    int brow = pm * 256, bcol = pn * 256;
    acc_t acc = {};
    gemm_mainloop(YB, DM, Wb, DM, DM, brow, bcol, acc, (u16*)lds, wave);
    const int lane_e = fresh_lane(), fr = lane_e & 15, fq = lane_e >> 4;
    ACC_FOREACH(ai, bj, m, n) {
      int row0 = brow + ai * HALF + wr * 64 + m * 16 + fq * 4, col = bcol + bj * HALF + wc * 32 + n * 16 + fr;
#pragma unroll
      for (int j = 0; j < 4; ++j) {
        size_t idx = (size_t)(row0 + j) * DM + col;
        P1[idx] = acc[ai][bj][m][n][j] / (1.f + __expf(-bf2f(GB[idx])));
      }
      __builtin_amdgcn_sched_barrier(0);
    }
  }
  for (int tile = blockIdx.x; tile < 64 * 8; tile += gridDim.x) {
    int pm, pn;
    tile_map(tile, 64, 8, pm, pn);
    int brow = pm * 256, bcol = pn * 256;
    acc_t acc = {};
    gemm_mainloop(YA, DM, Wa, DM, DM, brow, bcol, acc, (u16*)lds, wave);
    const int lane_e = fresh_lane(), fr = lane_e & 15, fq = lane_e >> 4;
    ACC_FOREACH(ai, bj, m, n) {
      int row0 = brow + ai * HALF + wr * 64 + m * 16 + fq * 4, col = bcol + bj * HALF + wc * 32 + n * 16 + fr;
#pragma unroll
      for (int j = 0; j < 4; ++j) {
        size_t idx = (size_t)(row0 + j) * DM + col;
        MG[idx] = f2bf(acc[ai][bj][m][n][j] / (1.f + __expf(-bf2f(GA[idx]))) + P1[idx]);
      }
      __builtin_amdgcn_sched_barrier(0);
    }
  }
}

__device__ __forceinline__ void phase_outproj(const Params& p, int layer, char* lds, int wave) {
  const u16* MG = (const u16*)(p.ws + WS_O);
  const u16* Wo = (const u16*)(p.ws + WS_WSM + (size_t)layer * WSM_STRIDE + 16 * MiB);
  const float* xres = layer == 0 ? p.x : p.out;
  const int wr = wave >> 2, wc = wave & 3;
  for (int tile = blockIdx.x; tile < 64 * 8; tile += gridDim.x) {
    int pm, pn;
    tile_map(tile, 64, 8, pm, pn);
    int brow = pm * 256, bcol = pn * 256;
    acc_t acc = {};
    gemm_mainloop(MG, DM, Wo, DM, DM, brow, bcol, acc, (u16*)lds, wave);
    const int lane_e = fresh_lane(), fr = lane_e & 15, fq = lane_e >> 4;
    ACC_FOREACH(ai, bj, m, n) {
      int row0 = brow + ai * HALF + wr * 64 + m * 16 + fq * 4, col = bcol + bj * HALF + wc * 32 + n * 16 + fr;
#pragma unroll
      for (int j = 0; j < 4; ++j) {
        size_t idx = (size_t)(row0 + j) * DM + col;
        p.out[idx] = xres[idx] + acc[ai][bj][m][n][j];
      }
      __builtin_amdgcn_sched_barrier(0);
    }
  }
}

#define MFMA32(a, b, c) __builtin_amdgcn_mfma_f32_32x32x16_bf16(a, b, c, 0, 0, 0)
#define MFMA16(a, b, c) __builtin_amdgcn_mfma_f32_16x16x32_bf16(a, b, c, 0, 0, 0)

__device__ __forceinline__ void mlstm_item(const Params& p, int layer, int grp, int slice, char* lds, int wave) {
  const int b = grp >> 3, hd = (grp >> 1) & 3, dir = grp & 1;
  const int lane = fresh_lane(), tid = wave * 64 + lane, w = wave, r = lane & 31, h = lane >> 5;
  u16* Qs = (u16*)lds;
  u16* Ks = Qs + 64 * 264;
  u16* Kt = Ks + 64 * 264;
  u16* Vt = Kt + 256 * 72;
  u16* Ps = Vt + 64 * 72;
  u16* Cb = Ps + 64 * 72;
  float* vec = (float*)(Cb + 64 * 264);
  float* v_a = vec, *v_c = vec + 64, *v_wi = vec + 128, *v_en = vec + 192, *v_wk = vec + 256, *v_qn = vec + 320,
         *v_den = vec + 384, *v_sc = vec + 448, *v_n = vec + 456;
  float* Xch = (float*)Ks;
  const u16* gq = (const u16*)(p.ws + WS_Q);
  const u16* gk = (const u16*)(p.ws + WS_K);
  const u16* gkt = (const u16*)(p.ws + WS_KT);
  const u16* gvt = (const u16*)(p.ws + WS_VT);
  const float* gates = (const float*)(p.ws + WS_GATES);
  u16* hdst = (u16*)(p.ws + (dir ? WS_WT0 : WS_XB16));

  __syncthreads();
  for (int i = tid; i < 64 * 264; i += 512) Cb[i] = 0;
  if (tid < 256) v_n[tid] = 0.f;
  float m_st = 0.f;
  f32x16 accC[2];
#pragma unroll
  for (int i = 0; i < 16; ++i) { accC[0][i] = 0.f; accC[1][i] = 0.f; }

  for (int st = 0; st < 64; ++st) {
    const int chunk = dir ? 63 - st : st;
    const size_t tok0 = (size_t)b * SEQ + chunk * 64;
    __syncthreads();
#pragma unroll
    for (int i = 0; i < 4; ++i) {
      int idx = tid + 512 * i, row = idx >> 5, c16 = idx & 31;
      *(bf16x8*)(Qs + row * 264 + c16 * 8) = *(const bf16x8*)(gq + (tok0 + row) * 1024 + hd * 256 + c16 * 8);
      *(bf16x8*)(Ks + row * 264 + c16 * 8) = *(const bf16x8*)(gk + (tok0 + row) * 1024 + hd * 256 + c16 * 8);
    }
#pragma unroll
    for (int i = 0; i < 4; ++i) {
      int idx = tid + 512 * i, row = idx >> 3, c16 = idx & 7;
      *(bf16x8*)(Kt + row * 72 + c16 * 8) = *(const bf16x8*)(gkt + ((tok0 >> 6) * 1024 + hd * 256 + row) * 64 + c16 * 8);
    }
    {
      int row = tid >> 3, c16 = tid & 7;
      *(bf16x8*)(Vt + row * 72 + c16 * 8) =
          *(const bf16x8*)(gvt + ((tok0 >> 6) * 2048 + hd * 512 + slice * 64 + row) * 64 + c16 * 8);
    }
    if (w == 0) {
      int L = lane, pos = dir ? 63 - L : L;
      const float* gp = gates + (tok0 + pos) * 16;
      float ipre = gp[dir * 4 + hd], fpre = gp[8 + dir * 4 + hd];
      float lf = fminf(fpre, 0.f) - log1pf(__expf(-fabsf(fpre)));
      float bc = lf;
#pragma unroll
      for (int o = 1; o < 64; o <<= 1) { float t = __shfl_up(bc, o); if (L >= o) bc += t; }
      float a = ipre - bc;
      float cm = a;
#pragma unroll
      for (int o = 1; o < 64; o <<= 1) { float t = __shfl_up(cm, o); if (L >= o) cm = fmaxf(cm, t); }
      float c = fmaxf(m_st, cm);
      float gtot = __shfl(bc, 63), c63 = __shfl(c, 63);
      v_a[pos] = a; v_c[pos] = c; v_wi[pos] = __expf(m_st - c); v_en[pos] = __expf(-(c + bc)); v_wk[pos] = __expf(a - c63);
      if (L == 0) v_sc[0] = __expf(m_st - c63);
      m_st = gtot + c63;
    }
    __syncthreads();
    if (w < 4) {
      int jb = w >> 1, sb = w & 1;
      bool skip = dir ? (sb < jb) : (sb > jb);
      f32x16 sacc;
#pragma unroll
      for (int i = 0; i < 16; ++i) sacc[i] = 0.f;
      if (!skip) {
#pragma unroll 4
        for (int kk = 0; kk < 16; ++kk) {
          bf16x8 af = *(const bf16x8*)(Qs + (jb * 32 + r) * 264 + kk * 16 + h * 8);
          bf16x8 bfr = *(const bf16x8*)(Ks + (sb * 32 + r) * 264 + kk * 16 + h * 8);
          sacc = MFMA32(af, bfr, sacc);
        }
      }
      int s = sb * 32 + r;
      float as_ = v_a[s];
#pragma unroll
      for (int reg = 0; reg < 16; ++reg) {
        int j = jb * 32 + (reg & 3) + 8 * (reg >> 2) + 4 * h;
        bool valid = dir ? (s >= j) : (s <= j);
        float pv = (valid && !skip) ? sacc[reg] * __expf(as_ - v_c[j]) : 0.f;
        Ps[j * 72 + s] = f2bf(pv);
      }
    } else {
      int t2 = tid - 256, j = t2 >> 2, part = t2 & 3;
      float sum = 0.f;
#pragma unroll
      for (int k8 = 0; k8 < 8; ++k8) {
        bf16x8 qv = *(const bf16x8*)(Qs + j * 264 + part * 64 + k8 * 8);
#pragma unroll
        for (int e = 0; e < 8; ++e) sum += bf2f((u16)qv[e]) * v_n[part * 64 + k8 * 8 + e];
      }
      sum += __shfl_xor(sum, 1);
      sum += __shfl_xor(sum, 2);
      if (part == 0) v_qn[j] = sum;
    }
    __syncthreads();
    {
      int t = w & 3, jb = t >> 1, vb = t & 1, kh = w >> 2;
      f32x16 acc;
#pragma unroll
      for (int i = 0; i < 16; ++i) acc[i] = 0.f;
#pragma unroll 4
      for (int kk = kh * 8; kk < kh * 8 + 8; ++kk) {
        bf16x8 af = *(const bf16x8*)(Qs + (jb * 32 + r) * 264 + kk * 16 + h * 8);
        bf16x8 bfr = *(const bf16x8*)(Cb + (vb * 32 + r) * 264 + kk * 16 + h * 8);
        acc = MFMA32(af, bfr, acc);
      }
#pragma unroll
      for (int reg = 0; reg < 16; ++reg) acc[reg] *= v_wi[jb * 32 + (reg & 3) + 8 * (reg >> 2) + 4 * h];
#pragma unroll
      for (int ss = kh * 2; ss < kh * 2 + 2; ++ss) {
        bf16x8 af = *(const bf16x8*)(Ps + (jb * 32 + r) * 72 + ss * 16 + h * 8);
        bf16x8 bfr = *(const bf16x8*)(Vt + (vb * 32 + r) * 72 + ss * 16 + h * 8);
        acc = MFMA32(af, bfr, acc);
      }
      if (kh == 1) {
#pragma unroll
        for (int reg = 0; reg < 16; ++reg) Xch[t * 1024 + reg * 64 + lane] = acc[reg];
        int t2 = tid - 256, j = t2 >> 2, part = t2 & 3;
        float sum = 0.f;
#pragma unroll
        for (int k8 = 0; k8 < 2; ++k8) {
          bf16x8 pv = *(const bf16x8*)(Ps + j * 72 + part * 16 + k8 * 8);
#pragma unroll
          for (int e = 0; e < 8; ++e) sum += bf2f((u16)pv[e]);
        }
        sum += __shfl_xor(sum, 1);
        sum += __shfl_xor(sum, 2);
        if (part == 0) v_den[j] = sum + v_wi[j] * v_qn[j];
      }
      __syncthreads();
      if (kh == 0) {
#pragma unroll
        for (int reg = 0; reg < 16; ++reg) {
          int j = jb * 32 + (reg & 3) + 8 * (reg >> 2) + 4 * h;
          float num = acc[reg] + Xch[t * 1024 + reg * 64 + lane];
          float dn = fmaxf(fabsf(v_den[j]), v_en[j]);
          hdst[(tok0 + j) * DM + hd * 512 + slice * 64 + vb * 32 + r] = f2bf(num / dn);
        }
      }
    }
    {
      int row = tid >> 3, c16 = tid & 7;
      bf16x8 vv = *(const bf16x8*)(Vt + row * 72 + c16 * 8);
#pragma unroll
      for (int e = 0; e < 8; ++e) vv[e] = (short)f2bf(bf2f((u16)vv[e]) * v_wk[c16 * 8 + e]);
      *(bf16x8*)(Vt + row * 72 + c16 * 8) = vv;
      if (tid >= 256) {
        int k = tid - 256;
        float sum = v_sc[0] * v_n[k];
#pragma unroll
        for (int k8 = 0; k8 < 8; ++k8) {
          bf16x8 kv = *(const bf16x8*)(Kt + k * 72 + k8 * 8);
#pragma unroll
          for (int e = 0; e < 8; ++e) sum += bf2f((u16)kv[e]) * v_wk[k8 * 8 + e];
        }
        v_n[k] = sum;
      }
    }
    __syncthreads();
    {
      float decay = v_sc[0];
#pragma unroll
      for (int i = 0; i < 16; ++i) { accC[0][i] *= decay; accC[1][i] *= decay; }
#pragma unroll
      for (int ss = 0; ss < 4; ++ss) {
        bf16x8 af = *(const bf16x8*)(Kt + (32 * w + r) * 72 + ss * 16 + h * 8);
        bf16x8 b0 = *(const bf16x8*)(Vt + (r) * 72 + ss * 16 + h * 8);
        bf16x8 b1 = *(const bf16x8*)(Vt + (32 + r) * 72 + ss * 16 + h * 8);
        accC[0] = MFMA32(af, b0, accC[0]);
        accC[1] = MFMA32(af, b1, accC[1]);
      }
#pragma unroll
      for (int vb = 0; vb < 2; ++vb)
#pragma unroll
        for (int g = 0; g < 4; ++g) {
          u16x4 pk = {f2bf(accC[vb][4 * g]), f2bf(accC[vb][4 * g + 1]), f2bf(accC[vb][4 * g + 2]), f2bf(accC[vb][4 * g + 3])};
          *(u16x4*)(Cb + (vb * 32 + r) * 264 + 32 * w + 8 * g + 4 * h) = pk;
        }
    }
  }
  __syncthreads();
}

template <int dir>
__device__ __forceinline__ void lru_item(const Params& p, int layer, int item, char* lds, int wave) {
  const int b = item >> 6, blk = (item >> 2) & 15, half = item & 1;
  const int lane = fresh_lane(), tid = wave * 64 + lane, w = wave, c = lane & 15, q = lane >> 4;
  u16* xcb = (u16*)lds;
  float* xcf = (float*)(lds + 64 * 136 * 2);
  const u16* xbp = (const u16*)(p.ws + WS_XBP);
  u16* hdst = (u16*)(p.ws + (dir ? WS_LHB : WS_LHF));
  const int cg = tid & 15, tt0 = tid >> 4;
  float cw[4][8], cbias[8];
#pragma unroll
  for (int e = 0; e < 8; ++e) {
    int ch = blk * 128 + cg * 8 + e;
    cbias[e] = p.conv_b[layer * DM + ch];
#pragma unroll
    for (int tap = 0; tap < 4; ++tap) cw[tap][e] = p.conv_w[(layer * 4 + tap) * DM + ch];
  }
  bf16x8 Br[4], Bi[4];
  float br = 0.f, bi = 0.f, sp = 0.f;
  const int chl = half * 64 + 16 * (w & 3) + c, ch = blk * 128 + chl;
  if (w < 4) {
    const u16* wrg = (const u16*)(p.ws + WS_WSM + (size_t)layer * WSM_STRIDE + 24 * MiB);
    const u16* wr_ = wrg + ((size_t)((dir * 2 + 0) * 16 + blk)) * 16384 + chl * 128;
    const u16* wi_ = wrg + ((size_t)((dir * 2 + 1) * 16 + blk)) * 16384 + chl * 128;
#pragma unroll
    for (int kk = 0; kk < 4; ++kk) {
      Br[kk] = *(const bf16x8*)(wr_ + kk * 32 + q * 8);
      Bi[kk] = *(const bf16x8*)(wi_ + kk * 32 + q * 8);
    }
    br = p.b_rg[((layer * 2 + dir) * 2 + 0) * DM + ch];
    bi = p.b_rg[((layer * 2 + dir) * 2 + 1) * DM + ch];
    float lam = p.lam[(layer * 2 + dir) * DM + ch];
    sp = fmaxf(-lam, 0.f) + log1pf(__expf(-fabsf(lam)));
  }
  float carry = 0.f;
  for (int ti = 0; ti < 64; ++ti) {
    const int tile = dir ? 63 - ti : ti, s0 = tile * 64;
    __syncthreads();
#pragma unroll
    for (int pass = 0; pass < 2; ++pass) {
      int tt = tt0 + 32 * pass, s = s0 + tt;
      float xc[8];
#pragma unroll
      for (int e = 0; e < 8; ++e) xc[e] = cbias[e];
#pragma unroll
      for (int tap = 0; tap < 4; ++tap) {
        int sp_ = s + tap - 2;
        if (sp_ >= 0 && sp_ < SEQ) {
          bf16x8 xv = *(const bf16x8*)(xbp + ((size_t)b * SEQ + sp_) * DM + blk * 128 + cg * 8);
#pragma unroll
          for (int e = 0; e < 8; ++e) xc[e] += cw[tap][e] * bf2f((u16)xv[e]);
        }
      }
      bf16x8 o8;
#pragma unroll
      for (int e = 0; e < 8; ++e) o8[e] = (short)f2bf(xc[e]);
      *(bf16x8*)(xcb + tt * 136 + cg * 8) = o8;
      if ((cg >> 3) == half) {
        float* d = xcf + tt * 68 + (cg & 7) * 8;
        *(float4*)d = make_float4(xc[0], xc[1], xc[2], xc[3]);
        *(float4*)(d + 4) = make_float4(xc[4], xc[5], xc[6], xc[7]);
      }
    }
    __syncthreads();
    if (w < 4) {
      f32x4 ar[4], ai_[4];
#pragma unroll
      for (int m = 0; m < 4; ++m) {
        ar[m] = f32x4{0.f, 0.f, 0.f, 0.f};
        ai_[m] = f32x4{0.f, 0.f, 0.f, 0.f};
#pragma unroll
        for (int kk = 0; kk < 4; ++kk) {
          bf16x8 af = *(const bf16x8*)(xcb + (16 * m + c) * 136 + kk * 32 + q * 8);
          ar[m] = MFMA16(af, Br[kk], ar[m]);
          ai_[m] = MFMA16(af, Bi[kk], ai_[m]);
        }
      }
#pragma unroll
      for (int mi = 0; mi < 4; ++mi) {
        const int m = dir ? 3 - mi : mi;
        float a_[4], u_[4];
#pragma unroll
        for (int i = 0; i < 4; ++i) {
          float rg = sigmoidf_(ar[m][i] + br), ig = sigmoidf_(ai_[m][i] + bi);
          float la = -8.f * sp * rg;
          float a = __expf(la);
          float xv = xcf[(16 * m + 4 * q + i) * 68 + 16 * w + c];
          a_[i] = a;
          u_[i] = sqrtf(fmaxf(1.f - a * a, 0.f)) * ig * xv;
        }
        float A4 = a_[0] * a_[1] * a_[2] * a_[3];
        float hv[4];
        if (!dir) {
          float U4 = ((u_[0] * a_[1] + u_[1]) * a_[2] + u_[2]) * a_[3] + u_[3];
          float hin = carry;
#pragma unroll
          for (int qq = 0; qq < 3; ++qq) {
            float Aq = __shfl(A4, qq * 16 + c), Uq = __shfl(U4, qq * 16 + c);
            if (qq < q) hin = Aq * hin + Uq;
          }
          hv[0] = a_[0] * hin + u_[0];
          hv[1] = a_[1] * hv[0] + u_[1];
          hv[2] = a_[2] * hv[1] + u_[2];
          hv[3] = a_[3] * hv[2] + u_[3];
          carry = __shfl(hv[3], 48 + c);
        } else {
          float U4 = ((u_[3] * a_[2] + u_[2]) * a_[1] + u_[1]) * a_[0] + u_[0];
          float hin = carry;
#pragma unroll
          for (int qq = 3; qq > 0; --qq) {
            float Aq = __shfl(A4, qq * 16 + c), Uq = __shfl(U4, qq * 16 + c);
            if (qq > q) hin = Aq * hin + Uq;
          }
          hv[3] = a_[3] * hin + u_[3];
          hv[2] = a_[2] * hv[3] + u_[2];
          hv[1] = a_[1] * hv[2] + u_[1];
          hv[0] = a_[0] * hv[1] + u_[0];
          carry = __shfl(hv[0], c);
        }
#pragma unroll
        for (int i = 0; i < 4; ++i)
          hdst[((size_t)b * SEQ + s0 + 16 * m + 4 * q + i) * DM + ch] = f2bf(hv[i]);
      }
    }
  }
  __syncthreads();
}

__device__ __forceinline__ void phase_mixers(const Params& p, int layer, char* lds, int wave) {
  for (int it = blockIdx.x; it < 512; it += gridDim.x) {
    if (it < 256) {
      int j = it >> 3;
      mlstm_item(p, layer, (it & 7) * 4 + (j >> 3), j & 7, lds, wave);
    } else {
      if (((it - 256) >> 1) & 1) lru_item<1>(p, layer, it - 256, lds, wave);
      else lru_item<0>(p, layer, it - 256, lds, wave);
    }
  }
}

__device__ __forceinline__ void phase_post(const Params& p, int layer, int wave) {
  int lane = fresh_lane(), wid = wave;
  int gw = blockIdx.x * 8 + wid, nw = gridDim.x * 8;
  const u16* hf = (const u16*)(p.ws + WS_XB16);
  const u16* hb = (const u16*)(p.ws + WS_WT0);
  const u16* lf = (const u16*)(p.ws + WS_LHF);
  const u16* lb = (const u16*)(p.ws + WS_LHB);
  const u16* o = (const u16*)(p.ws + WS_O);
  u16* za = (u16*)(p.ws + WS_ZA);
  u16* zb = (u16*)(p.ws + WS_ZB);
  for (int wi = gw; wi < T * 4; wi += nw) {
    size_t off = (size_t)(wi >> 2) * DM + (wi & 3) * 512 + lane * 8;
    int col = (wi & 3) * 512 + lane * 8;
    bf16x8 f8 = *(const bf16x8*)(hf + off), b8 = *(const bf16x8*)(hb + off);
    bf16x8 o8 = *(const bf16x8*)(o + off), z8 = *(const bf16x8*)(za + off);
    bf16x8 lf8 = *(const bf16x8*)(lf + off), lb8 = *(const bf16x8*)(lb + off), zb8 = *(const bf16x8*)(zb + off);
    float hv[8], ss = 0.f;
#pragma unroll
    for (int e = 0; e < 8; ++e) { hv[e] = bf2f((u16)f8[e]) + bf2f((u16)b8[e]); ss += hv[e] * hv[e]; }
#pragma unroll
    for (int s = 32; s >= 1; s >>= 1) ss += __shfl_xor(ss, s);
    float rn = rsqrtf(ss * (1.f / 512.f) + EPS);
    const float* hg = p.head_g + layer * DM + col;
    bf16x8 ya, yb;
#pragma unroll
    for (int e = 0; e < 8; ++e) {
      float ov = bf2f((u16)o8[e]), zv = bf2f((u16)z8[e]);
      float y = hv[e] * rn * hg[e] * sigmoidf_(ov) * (zv * sigmoidf_(zv));
      ya[e] = (short)f2bf(y);
      float zbv = bf2f((u16)zb8[e]);
      float y2 = (bf2f((u16)lf8[e]) + bf2f((u16)lb8[e])) * (zbv * sigmoidf_(zbv));
      yb[e] = (short)f2bf(y2);
    }
    *(bf16x8*)(za + off) = ya;
    *(bf16x8*)(zb + off) = yb;
  }
}

constexpr int NPHASE = 13;
#define PH(n, code)                         \
  if (ph_lo <= (n) && (n) < ph_hi) {        \
    if ((n) > ph_lo) cg::this_grid().sync(); \
    code;                                   \
  }
__global__ void __launch_bounds__(512, 2) mega(Params p, int ph_lo, int ph_hi) {
  extern __shared__ __attribute__((aligned(16))) char lds[];
  const int wave = __builtin_amdgcn_readfirstlane(threadIdx.x >> 6);
  PH(0, { phase_convert(p, lds, wave); phase_rowpass(p, 0, p.x, wave); })
  PH(1, phase_inproj(p, 0, lds, wave))
  PH(2, phase_mixers(p, 0, lds, wave))
  PH(3, phase_post(p, 0, wave))
  PH(4, phase_branch(p, 0, lds, wave))
  PH(5, phase_outproj(p, 0, lds, wave))
  PH(6, phase_rowpass(p, 1, p.out, wave))
  PH(7, phase_inproj(p, 1, lds, wave))
  PH(8, phase_mixers(p, 1, lds, wave))
  PH(9, phase_post(p, 1, wave))
  PH(10, phase_branch(p, 1, lds, wave))
  PH(11, phase_outproj(p, 1, lds, wave))
  PH(12, phase_final(p, wave))
}

extern "C" void kernel_launch(void* const* d_in, const int* in_sizes, int n_in, void* d_out, int out_size, void* d_ws,
                              size_t ws_size, hipStream_t stream) {
  static int grid = 0;
  if (grid == 0) {
    if (ws_size < WS_END) { fprintf(stderr, "workspace too small: %zu < %zu\n", ws_size, (size_t)WS_END); grid = -1; return; }
    int dev = 0, cus = 0, per_cu = 0;
    hipGetDevice(&dev);
    hipDeviceGetAttribute(&cus, hipDeviceAttributeMultiprocessorCount, dev);
    if (hipFuncSetAttribute((const void*)mega, hipFuncAttributeMaxDynamicSharedMemorySize, LDS_BYTES) != hipSuccess) {
      fprintf(stderr, "hipFuncSetAttribute failed\n"); grid = -1; return;
    }
    hipOccupancyMaxActiveBlocksPerMultiprocessor(&per_cu, (const void*)mega, 512, LDS_BYTES);
    if (per_cu < 1) { fprintf(stderr, "occupancy query says %d\n", per_cu); per_cu = 1; }
    (void)hipGetLastError();
    grid = cus * 1;
  }
  if (grid < 0) return;
  Params p{};
  p.x = (const float*)d_in[0]; p.norm_g = (const float*)d_in[1]; p.w_in = (const float*)d_in[2];
  p.b_if = (const float*)d_in[3]; p.head_g = (const float*)d_in[4]; p.conv_w = (const float*)d_in[5];
  p.conv_b = (const float*)d_in[6]; p.w_rg = (const float*)d_in[7]; p.b_rg = (const float*)d_in[8];
  p.lam = (const float*)d_in[9]; p.w_a = (const float*)d_in[10]; p.w_b = (const float*)d_in[11];
  p.w_o = (const float*)d_in[12]; p.final_g = (const float*)d_in[13];
  p.out = (float*)d_out; p.ws = (unsigned char*)d_ws;
#if COOP
  int lo = 0, hi = NPHASE;
  void* args[] = {&p, &lo, &hi};
  hipError_t e = hipLaunchCooperativeKernel((const void*)mega, dim3(grid), dim3(512), args, LDS_BYTES, stream);
  if (e != hipSuccess) fprintf(stderr, "cooperative launch failed: %s (grid %d)\n", hipGetErrorString(e), grid);
#else
  for (int ph = 0; ph < NPHASE; ++ph) hipLaunchKernelGGL(mega, dim3(grid), dim3(512), LDS_BYTES, stream, p, ph, ph + 1);
#endif
}
```

```cpp
#include <hip/hip_runtime.h>
#include <hip/hip_cooperative_groups.h>
#include <cstdio>
#include <cstdint>
namespace cg = cooperative_groups;

#ifndef PROBE_DUP
#define PROBE_DUP 0
#endif
#ifndef COOP
#define COOP 1
#endif

typedef unsigned short u16;
using bf16x8 = __attribute__((ext_vector_type(8))) short;
using u16x4 = __attribute__((ext_vector_type(4))) unsigned short;
using f32x4 = __attribute__((ext_vector_type(4))) float;
using f32x16 = __attribute__((ext_vector_type(16))) float;

constexpr int T = 16384, SEQ = 4096, DM = 2048, NIN = 16400;
constexpr float EPS = 1e-6f;
constexpr size_t MiB = 1ull << 20;
constexpr size_t WS_WT0 = 0;
constexpr size_t WS_WT1 = 64 * MiB;
constexpr size_t WS_WSM = 128 * MiB;
constexpr size_t WSM_STRIDE = 27 * MiB;
constexpr size_t WS_Q = 182 * MiB, WS_K = 214 * MiB, WS_KT = 246 * MiB, WS_VT = 278 * MiB, WS_O = 342 * MiB,
                 WS_ZA = 406 * MiB, WS_XBP = 470 * MiB, WS_ZB = 534 * MiB, WS_GA = 598 * MiB, WS_GB = 662 * MiB,
                 WS_XB16 = 726 * MiB,
                 WS_LHF = 790 * MiB, WS_LHB = 854 * MiB, WS_RS = 918 * MiB, WS_GATES = 918 * MiB + 65536,
                 WS_END = 920 * MiB;
constexpr int LDS_BYTES = 160 * 1024;

struct Params {
  const float *x, *norm_g, *w_in, *b_if, *head_g, *conv_w, *conv_b, *w_rg, *b_rg, *lam, *w_a, *w_b, *w_o, *final_g;
  float* out;
  unsigned char* ws;
};

__device__ __forceinline__ u16 f2bf(float f) {
  uint32_t u = __float_as_uint(f);
  u += 0x7fffu + ((u >> 16) & 1u);
  return (u16)(u >> 16);
}
__device__ __forceinline__ float bf2f(u16 h) { return __uint_as_float(((uint32_t)h) << 16); }
__device__ __forceinline__ int fresh_lane() {
  int l;
  asm volatile("v_mbcnt_lo_u32_b32 %0, -1, 0\n\tv_mbcnt_hi_u32_b32 %0, -1, %0" : "=v"(l));
  return l & 63;
}
#define TID_DECL const int tid = wave * 64 + fresh_lane()
__device__ __forceinline__ float sigmoidf_(float x) { return 1.f / (1.f + __expf(-x)); }

__device__ __forceinline__ void tconv_tile(const float* __restrict__ src, long ld_src, int k0, int n0s, u16* __restrict__ dst,
                           long ld_dst, int n0d, const float* __restrict__ rowscale, float cs, float* tile, int wave) {
  TID_DECL;
  int c = tid & 63, r = tid >> 6;
#pragma unroll
  for (int i = 0; i < 8; ++i) {
    int kl = r + 8 * i;
    float v = src[(long)(k0 + kl) * ld_src + n0s + c];
    if (rowscale) v *= rowscale[k0 + kl];
    tile[kl * 65 + c] = v * cs;
  }
  __syncthreads();
#pragma unroll
  for (int i = 0; i < 8; ++i) {
    int nl = r + 8 * i;
    dst[(long)(n0d + nl) * ld_dst + k0 + c] = f2bf(tile[c * 65 + nl]);
  }
  __syncthreads();
}

__device__ __forceinline__ void phase_convert(const Params& p, char* lds, int wave) {
  TID_DECL;
  float* tile = (float*)lds;
  constexpr int PER_LAYER = 8192 + 3072 + 256 + 1;
  for (int it = blockIdx.x; it < 2 * PER_LAYER; it += gridDim.x) {
    int l = it / PER_LAYER, r = it % PER_LAYER;
    unsigned char* wsm = p.ws + WS_WSM + (size_t)l * WSM_STRIDE;
    if (r < 8192) {
      int kt = r & 31, nt = r >> 5;
      int n0d = nt * 64, n0s = n0d < 8192 ? n0d : n0d + 16;
      float cs = (n0d >= 1024 && n0d < 2048) ? 0.0625f : 1.f;
      u16* dst = (u16*)(p.ws + (l ? WS_WT1 : WS_WT0));
      tconv_tile(p.w_in + (size_t)l * DM * NIN, NIN, kt * 64, n0s, dst, DM, n0d, p.norm_g + l * DM, cs, tile, wave);
    } else if (r < 8192 + 3072) {
      int q = r - 8192, which = q >> 10, tt = q & 1023, kt = tt & 31, nt = tt >> 5;
      const float* src = (which == 0 ? p.w_a : which == 1 ? p.w_b : p.w_o) + (size_t)l * DM * DM;
      u16* dst = (u16*)(wsm + (size_t)which * 8 * MiB);
      tconv_tile(src, DM, kt * 64, nt * 64, dst, DM, nt * 64, nullptr, 1.f, tile, wave);
    } else if (r < 8192 + 3072 + 256) {
      int q = r - 8192 - 3072, mat = q >> 2, tt = q & 3;
      const float* src = p.w_rg + ((size_t)l * 64 + mat) * 16384;
      u16* dst = (u16*)(wsm + 24 * MiB) + (size_t)mat * 16384;
      tconv_tile(src, 128, (tt & 1) * 64, (tt >> 1) * 64, dst, 128, (tt >> 1) * 64, nullptr, 1.f, tile, wave);
    } else {
      u16* dst = (u16*)(wsm + 26 * MiB);
      const float* src = p.w_in + (size_t)l * DM * NIN;
      for (int i = tid; i < 16 * DM; i += 512) {
        int j = i >> 11, k = i & 2047;
        dst[i] = f2bf(src[(size_t)k * NIN + 8192 + j] * p.norm_g[l * DM + k]);
      }
    }
  }
}

__device__ __forceinline__ void phase_rowpass(const Params& p, int layer, const float* __restrict__ xin, int wave) {
  int lane = fresh_lane(), wid = wave;
  int gw = blockIdx.x * 8 + wid, nw = gridDim.x * 8;
  int r = lane & 15, q = lane >> 4;
  u16* xb16 = (u16*)(p.ws + WS_XB16);
  float* rs = (float*)(p.ws + WS_RS);
  float* gates = (float*)(p.ws + WS_GATES);
  const u16* wg = (const u16*)(p.ws + WS_WSM + (size_t)layer * WSM_STRIDE + 26 * MiB);
  for (int rt = gw; rt < T / 16; rt += nw) {
    int row = rt * 16 + r;
    const float* xr = xin + (size_t)row * DM + q * 8;
    f32x4 acc = {0.f, 0.f, 0.f, 0.f};
    float ss = 0.f;
#pragma unroll 4
    for (int kk = 0; kk < 64; ++kk) {
      float4 a0 = *(const float4*)(xr + kk * 32);
      float4 a1 = *(const float4*)(xr + kk * 32 + 4);
      ss += a0.x * a0.x + a0.y * a0.y + a0.z * a0.z + a0.w * a0.w + a1.x * a1.x + a1.y * a1.y + a1.z * a1.z + a1.w * a1.w;
      bf16x8 af;
      af[0] = (short)f2bf(a0.x); af[1] = (short)f2bf(a0.y); af[2] = (short)f2bf(a0.z); af[3] = (short)f2bf(a0.w);
      af[4] = (short)f2bf(a1.x); af[5] = (short)f2bf(a1.y); af[6] = (short)f2bf(a1.z); af[7] = (short)f2bf(a1.w);
      *(bf16x8*)(xb16 + (size_t)row * DM + kk * 32 + q * 8) = af;
      bf16x8 bfr = *(const bf16x8*)(wg + (size_t)r * DM + kk * 32 + q * 8);
      acc = __builtin_amdgcn_mfma_f32_16x16x32_bf16(af, bfr, acc, 0, 0, 0);
    }
    ss += __shfl_xor(ss, 16);
    ss += __shfl_xor(ss, 32);
    float rsv = rsqrtf(ss * (1.f / DM) + EPS);
    if (q == 0) rs[row] = rsv;
    float bias = p.b_if[layer * 16 + r];
#pragma unroll
    for (int j = 0; j < 4; ++j) {
      float rr = __shfl(rsv, q * 4 + j);
      gates[(size_t)(rt * 16 + q * 4 + j) * 16 + r] = acc[j] * rr + bias;
    }
  }
}

__device__ __forceinline__ void phase_final(const Params& p, int wave) {
  int lane = fresh_lane(), wid = wave;
  int gw = blockIdx.x * 8 + wid, nw = gridDim.x * 8;
  for (int row = gw; row < T; row += nw) {
    float* xr = p.out + (size_t)row * DM;
    float4 v[8];
    float ss = 0.f;
#pragma unroll
    for (int i = 0; i < 8; ++i) {
      v[i] = *(const float4*)(xr + i * 256 + lane * 4);
      ss += v[i].x * v[i].x + v[i].y * v[i].y + v[i].z * v[i].z + v[i].w * v[i].w;
    }
#pragma unroll
    for (int o = 32; o >= 1; o >>= 1) ss += __shfl_xor(ss, o);
    float rsv = rsqrtf(ss * (1.f / DM) + EPS);
#pragma unroll
    for (int i = 0; i < 8; ++i) {
      float4 g = *(const float4*)(p.final_g + i * 256 + lane * 4);
      float4 o4;
      o4.x = v[i].x * rsv * g.x; o4.y = v[i].y * rsv * g.y; o4.z = v[i].z * rsv * g.z; o4.w = v[i].w * rsv * g.w;
      *(float4*)(xr + i * 256 + lane * 4) = o4;
    }
  }
}

constexpr int BM = 256, BK = 64, HALF = 128, HT = HALF * BK;
__device__ __forceinline__ int lds_byte(int r, int c) {
  int st = (r >> 4) * 2 + (c >> 5), rr = r & 15, cc = c & 31, ob = rr * 64 + cc * 2;
  return st * 1024 + (ob ^ (((ob >> 9) & 1) << 5));
}
__device__ __forceinline__ void stage_rc(int b, int& R, int& C) {
  int st = b / 1024, sb = b % 1024, swz = sb ^ (((sb >> 9) & 1) << 5);
  R = (st >> 1) * 16 + swz / 64;
  C = (st & 1) * 32 + (swz % 64) / 2;
}

typedef f32x4 acc_t[2][2][4][2];

__device__ __forceinline__ void gemm_mainloop(const u16* __restrict__ A, long lda, const u16* __restrict__ Bt, long ldb,
                                              int K, int brow, int bcol, acc_t& acc, u16* shm, int wave) {
#define SA(b, h) (shm + ((b) * 2 + (h)) * HT)
#define SB(b, h) (shm + (4 + (b) * 2 + (h)) * HT)
#define STAGE(P, BASE, LD, br, kt)                                                                             \
  do {                                                                                                         \
    const u16* _gb = (BASE) + ((size_t)(br) * 2048 + (size_t)(kt) * BK);                                       \
    __builtin_amdgcn_global_load_lds((const unsigned*)(_gb + soff0), (unsigned*)((char*)(P) + tid * 16), 16, 0, 0);        \
    __builtin_amdgcn_global_load_lds((const unsigned*)(_gb + soff1), (unsigned*)((char*)(P) + tid * 16 + 8192), 16, 0, 0); \
  } while (0)
#define LDA(dst, b, h)                                                                                         \
  _Pragma("unroll") for (int m = 0; m < 4; ++m)                                                                \
    _Pragma("unroll") for (int k = 0; k < 2; ++k)                                                              \
  dst[m][k] = *reinterpret_cast<const bf16x8*>((char*)SA(b, h) + lds_byte(wr * 64 + m * 16 + fr, k * 32 + fq * 8))
#define LDB(dst, b, h)                                                                                         \
  _Pragma("unroll") for (int n = 0; n < 2; ++n)                                                                \
    _Pragma("unroll") for (int k = 0; k < 2; ++k)                                                              \
  dst[n][k] = *reinterpret_cast<const bf16x8*>((char*)SB(b, h) + lds_byte(wc * 32 + n * 16 + fr, k * 32 + fq * 8))
#define MMA(ai, bj, At, Bt_)                                                                                   \
  do {                                                                                                         \
    __builtin_amdgcn_s_setprio(1);                                                                             \
    _Pragma("unroll") for (int m = 0; m < 4; ++m)                                                              \
      _Pragma("unroll") for (int n = 0; n < 2; ++n)                                                            \
        _Pragma("unroll") for (int k = 0; k < 2; ++k)                                                          \
          acc[ai][bj][m][n] = __builtin_amdgcn_mfma_f32_16x16x32_bf16(At[m][k], Bt_[n][k], acc[ai][bj][m][n], 0, 0, 0); \
    __builtin_amdgcn_s_setprio(0);                                                                             \
  } while (0)
#define WAIT_V(n) asm volatile("s_waitcnt vmcnt(" #n ")" ::: "memory")
#define WAIT_L(n) asm volatile("s_waitcnt lgkmcnt(" #n ")" ::: "memory")
#define BAR __builtin_amdgcn_s_barrier()
#define SCHED __builtin_amdgcn_sched_barrier(0)
  const int lane = fresh_lane(), tid = wave * 64 + lane;
  int wid = wave, wr = wid >> 2, wc = wid & 3, fr = lane & 15, fq = lane >> 4;
  bf16x8 At[4][2], B0[2][2], B1[2][2];
  int nt = K / BK;
  unsigned soff0, soff1;
  { int _r, _c; stage_rc(tid * 16, _r, _c); soff0 = _r * 2048 + _c; stage_rc(tid * 16 + 8192, _r, _c); soff1 = _r * 2048 + _c; }
  STAGE(SB(0, 0), Bt, ldb, bcol, 0); STAGE(SA(0, 0), A, lda, brow, 0);
  STAGE(SB(0, 1), Bt, ldb, bcol + HALF, 0); STAGE(SA(0, 1), A, lda, brow + HALF, 0);
  if (wr == 1) BAR;
  WAIT_V(4); BAR;
  STAGE(SB(1, 0), Bt, ldb, bcol, 1); STAGE(SA(1, 0), A, lda, brow, 1); STAGE(SB(1, 1), Bt, ldb, bcol + HALF, 1);
  WAIT_V(6); BAR;
  for (int t = 0; t < nt - 2; t += 2) {
    LDB(B0, 0, 0); SCHED; LDA(At, 0, 0); STAGE(SA(1, 1), A, lda, brow + HALF, t + 1);
    WAIT_L(8); BAR; WAIT_L(0); MMA(0, 0, At, B0); BAR; SCHED;
    LDB(B1, 0, 1); STAGE(SB(0, 0), Bt, ldb, bcol, t + 2);
    BAR; WAIT_L(0); MMA(0, 1, At, B1); BAR;
    LDA(At, 0, 1); STAGE(SA(0, 0), A, lda, brow, t + 2);
    BAR; WAIT_L(0); MMA(1, 0, At, B0); BAR; SCHED;
    STAGE(SB(0, 1), Bt, ldb, bcol + HALF, t + 2);
    WAIT_V(6); BAR; MMA(1, 1, At, B1); BAR;
    LDB(B0, 1, 0); SCHED; LDA(At, 1, 0); STAGE(SA(0, 1), A, lda, brow + HALF, t + 2);
    WAIT_L(8); BAR; WAIT_L(0); MMA(0, 0, At, B0); BAR; SCHED;
    LDB(B1, 1, 1); STAGE(SB(1, 0), Bt, ldb, bcol, t + 3);
    BAR; WAIT_L(0); MMA(0, 1, At, B1); BAR;
    LDA(At, 1, 1); STAGE(SA(1, 0), A, lda, brow, t + 3);
    BAR; WAIT_L(0); MMA(1, 0, At, B0); BAR; SCHED;
    STAGE(SB(1, 1), Bt, ldb, bcol + HALF, t + 3);
    WAIT_V(6); BAR; MMA(1, 1, At, B1); BAR;
  }
  { LDB(B0, 0, 0); LDA(At, 0, 0); STAGE(SA(1, 1), A, lda, brow + HALF, nt - 1);
    BAR; WAIT_L(0); MMA(0, 0, At, B0); BAR;
    LDB(B1, 0, 1); BAR; WAIT_L(0); MMA(0, 1, At, B1); BAR;
    LDA(At, 0, 1); WAIT_V(4); BAR; WAIT_L(0); MMA(1, 0, At, B0); MMA(1, 1, At, B1); BAR; }
  { LDB(B0, 1, 0); LDA(At, 1, 0); WAIT_V(2); BAR; WAIT_L(0); MMA(0, 0, At, B0); BAR;
    LDB(B1, 1, 1); WAIT_V(0); BAR; WAIT_L(0); MMA(0, 1, At, B1); BAR;
    LDA(At, 1, 1); BAR; WAIT_L(0); MMA(1, 0, At, B0); MMA(1, 1, At, B1); BAR; }
  if (wr == 0) BAR;
#undef SA
#undef SB
}

__device__ __forceinline__ void tile_map(int wgid, int nM, int nN, int& pm, int& pn) {
  int nwg = nM * nN;
  int q = nwg / 8, r = nwg % 8, xcd = wgid % 8, off = wgid / 8;
  wgid = (xcd < r ? xcd * (q + 1) : r * (q + 1) + (xcd - r) * q) + off;
  int nig = 8 * nN, gid = wgid / nig, fm = gid * 8, gsz = min(nM - fm, 8);
  pm = fm + ((wgid % nig) % gsz);
  pn = (wgid % nig) / gsz;
}

#define ACC_FOREACH(ai, bj, m, n)                                                                   \
  _Pragma("unroll") for (int ai = 0; ai < 2; ++ai) _Pragma("unroll") for (int bj = 0; bj < 2; ++bj) \
      _Pragma("unroll") for (int m = 0; m < 4; ++m) _Pragma("unroll") for (int n = 0; n < 2; ++n)

__device__ __forceinline__ void phase_inproj(const Params& p, int layer, char* lds, int wave) {
  const u16* A = (const u16*)(p.ws + WS_XB16);
  const u16* Bt = (const u16*)(p.ws + (layer ? WS_WT1 : WS_WT0));
  const float* rs = (const float*)(p.ws + WS_RS);
  const int wr = wave >> 2, wc = wave & 3;
  for (int tile = blockIdx.x; tile < 64 * 64; tile += gridDim.x) {
    int pm, pn;
    tile_map(tile, 64, 64, pm, pn);
    int brow = pm * 256, bcol = pn * 256;
    acc_t acc = {};
    gemm_mainloop(A, DM, Bt, DM, DM, brow, bcol, acc, (u16*)lds, wave);
    const int lane_e = fresh_lane(), fr = lane_e & 15, fq = lane_e >> 4;
    int seg = bcol < 1024 ? 0 : bcol < 2048 ? 1 : bcol < 4096 ? 2 : 3 + (bcol - 4096) / 2048;
    int cbase = seg == 0 ? 0 : seg == 1 ? 1024 : seg == 2 ? 2048 : 4096 + (seg - 3) * 2048;
    int w = seg < 2 ? 1024 : 2048;
    const size_t offs[9] = {WS_Q, WS_K, 0, WS_O, WS_ZA, WS_XBP, WS_ZB, WS_GA, WS_GB};
    size_t off_rm = seg == 0 ? WS_Q : seg == 1 ? WS_K : seg == 3 ? WS_O : seg == 4 ? WS_ZA : seg == 5 ? WS_XBP
                  : seg == 6 ? WS_ZB : seg == 7 ? WS_GA : WS_GB;
    (void)offs;
    u16* dst_rm = (u16*)(p.ws + off_rm) + (bcol - cbase);
    u16* dst_t = (u16*)(p.ws + (seg == 1 ? WS_KT : WS_VT)) + (size_t)(bcol - cbase) * 64;
    const bool do_rm = seg != 2, do_t = (seg == 1 || seg == 2);
#pragma unroll
    for (int ai = 0; ai < 2; ++ai)
#pragma unroll
      for (int m = 0; m < 4; ++m) {
        int row0 = brow + ai * HALF + wr * 64 + m * 16 + fq * 4;
        float r0 = rs[row0], r1 = rs[row0 + 1], r2 = rs[row0 + 2], r3 = rs[row0 + 3];
#pragma unroll
        for (int bj = 0; bj < 2; ++bj)
#pragma unroll
          for (int n = 0; n < 2; ++n) {
            int cl = bj * HALF + wc * 32 + n * 16 + fr;
            f32x4 a = acc[ai][bj][m][n];
            u16 h0 = f2bf(a[0] * r0), h1 = f2bf(a[1] * r1), h2 = f2bf(a[2] * r2), h3 = f2bf(a[3] * r3);
            if (do_t) {
              u16x4 pk = {h0, h1, h2, h3};
              *(u16x4*)(dst_t + ((size_t)(row0 >> 6) * w + cl) * 64 + (row0 & 63)) = pk;
            }
            if (do_rm) {
              u16* d = dst_rm + (size_t)row0 * w + cl;
              d[0] = h0; d[w] = h1; d[2 * w] = h2; d[3 * w] = h3;
            }
            __builtin_amdgcn_sched_barrier(0);
          }
      }
  }
}

__device__ __forceinline__ void phase_branch(const Params& p, int layer, char* lds, int wave) {
  const u16* YA = (const u16*)(p.ws + WS_ZA);
  const u16* YB = (const u16*)(p.ws + WS_ZB);
  const u16* GA = (const u16*)(p.ws + WS_GA);
  const u16* GB = (const u16*)(p.ws + WS_GB);
  const u16* Wa = (const u16*)(p.ws + WS_WSM + (size_t)layer * WSM_STRIDE);
  const u16* Wb = Wa + 4 * MiB;
  u16* MG = (u16*)(p.ws + WS_O);
  const int wr = wave >> 2, wc = wave & 3;
  float* P1 = (float*)(p.ws + WS_Q);
  for (int tile = blockIdx.x; tile < 64 * 8; tile += gridDim.x) {
    int pm, pn;
    tile_map(tile, 64, 8, pm, pn);
    int brow = pm * 256, bcol = pn * 256;
    acc_t acc = {};
    gemm_mainloop(YB, DM, Wb, DM, DM, brow, bcol, acc, (u16*)lds, wave);
    const int lane_e = fresh_lane(), fr = lane_e & 15, fq = lane_e >> 4;
    ACC_FOREACH(ai, bj, m, n) {
      int row0 = brow + ai * HALF + wr * 64 + m * 16 + fq * 4, col = bcol + bj * HALF + wc * 32 + n * 16 + fr;
#pragma unroll
      for (int j = 0; j < 4; ++j) {
        size_t idx = (size_t)(row0 + j) * DM + col;
        P1[idx] = acc[ai][bj][m][n][j] / (1.f + __expf(-bf2f(GB[idx])));
      }
      __builtin_amdgcn_sched_barrier(0);
    }
  }
  for (int tile = blockIdx.x; tile < 64 * 8; tile += gridDim.x) {
    int pm, pn;
    tile_map(tile, 64, 8, pm, pn);
    int brow = pm * 256, bcol = pn * 256;
    acc_t acc = {};
    gemm_mainloop(YA, DM, Wa, DM, DM, brow, bcol, acc, (u16*)lds, wave);
    const int lane_e = fresh_lane(), fr = lane_e & 15, fq = lane_e >> 4;
    ACC_FOREACH(ai, bj, m, n) {
      int row0 = brow + ai * HALF + wr * 64 + m * 16 + fq * 4, col = bcol + bj * HALF + wc * 32 + n * 16 + fr;
#pragma unroll
      for (int j = 0; j < 4; ++j) {
        size_t idx = (size_t)(row0 + j) * DM + col;
        MG[idx] = f2bf(acc[ai][bj][m][n][j] / (1.f + __expf(-bf2f(GA[idx]))) + P1[idx]);
      }
      __builtin_amdgcn_sched_barrier(0);
    }
  }
}

__device__ __forceinline__ void phase_outproj(const Params& p, int layer, char* lds, int wave) {
  const u16* MG = (const u16*)(p.ws + WS_O);
  const u16* Wo = (const u16*)(p.ws + WS_WSM + (size_t)layer * WSM_STRIDE + 16 * MiB);
  const float* xres = layer == 0 ? p.x : p.out;
  const int wr = wave >> 2, wc = wave & 3;
  for (int tile = blockIdx.x; tile < 64 * 8; tile += gridDim.x) {
    int pm, pn;
    tile_map(tile, 64, 8, pm, pn);
    int brow = pm * 256, bcol = pn * 256;
    acc_t acc = {};
    gemm_mainloop(MG, DM, Wo, DM, DM, brow, bcol, acc, (u16*)lds, wave);
    const int lane_e = fresh_lane(), fr = lane_e & 15, fq = lane_e >> 4;
    ACC_FOREACH(ai, bj, m, n) {
      int row0 = brow + ai * HALF + wr * 64 + m * 16 + fq * 4, col = bcol + bj * HALF + wc * 32 + n * 16 + fr;
#pragma unroll
      for (int j = 0; j < 4; ++j) {
        size_t idx = (size_t)(row0 + j) * DM + col;
        p.out[idx] = xres[idx] + acc[ai][bj][m][n][j];
      }
      __builtin_amdgcn_sched_barrier(0);
    }
  }
}

#define MFMA32(a, b, c) __builtin_amdgcn_mfma_f32_32x32x16_bf16(a, b, c, 0, 0, 0)
#define MFMA16(a, b, c) __builtin_amdgcn_mfma_f32_16x16x32_bf16(a, b, c, 0, 0, 0)

__device__ __forceinline__ void mlstm_item(const Params& p, int layer, int grp, int slice, char* lds, int wave) {
  const int b = grp >> 3, hd = (grp >> 1) & 3, dir = grp & 1;
  const int lane = fresh_lane(), tid = wave * 64 + lane, w = wave, r = lane & 31, h = lane >> 5;
  u16* Qs = (u16*)lds;
  u16* Ks = Qs + 64 * 264;
  u16* Kt = Ks + 64 * 264;
  u16* Vt = Kt + 256 * 72;
  u16* Ps = Vt + 64 * 72;
  u16* Cb = Ps + 64 * 72;
  float* vec = (float*)(Cb + 64 * 264);
  float* v_qn = vec + 656, *v_den = vec + 720, *v_n = vec + 784;
  float* Xch = (float*)Ks;
  const u16* gq = (const u16*)(p.ws + WS_Q);
  const u16* gk = (const u16*)(p.ws + WS_K);
  const u16* gkt = (const u16*)(p.ws + WS_KT);
  const u16* gvt = (const u16*)(p.ws + WS_VT);
  const float* gates = (const float*)(p.ws + WS_GATES);
  u16* hdst = (u16*)(p.ws + (dir ? WS_WT0 : WS_XB16));

  bf16x8 pq[4], pk[4], pkt[4], pv;
  float g_i = 0.f, g_f = 0.f, m_st = 0.f;
#define ML_ISSUE(st_)                                                                                          \
  do {                                                                                                         \
    const int chunk_ = dir ? 63 - (st_) : (st_);                                                               \
    const size_t tok_ = (size_t)b * SEQ + chunk_ * 64;                                                         \
    if (w == 0) {                                                                                              \
      const float* gp = gates + (tok_ + (dir ? 63 - lane : lane)) * 16;                                        \
      g_i = gp[dir * 4 + hd];                                                                                  \
      g_f = gp[8 + dir * 4 + hd];                                                                              \
    }                                                                                                          \
    _Pragma("unroll") for (int i = 0; i < 4; ++i) {                                                            \
      int idx = tid + 512 * i, row = idx >> 5, c16 = idx & 31;                                                 \
      pq[i] = *(const bf16x8*)(gq + (tok_ + row) * 1024 + hd * 256 + c16 * 8);                                 \
      pk[i] = *(const bf16x8*)(gk + (tok_ + row) * 1024 + hd * 256 + c16 * 8);                                 \
    }                                                                                                          \
    _Pragma("unroll") for (int i = 0; i < 4; ++i) {                                                            \
      int idx = tid + 512 * i, row = idx >> 3, c16 = idx & 7;                                                  \
      pkt[i] = *(const bf16x8*)(gkt + ((tok_ >> 6) * 1024 + hd * 256 + row) * 64 + c16 * 8);                   \
    }                                                                                                          \
    pv = *(const bf16x8*)(gvt + ((tok_ >> 6) * 2048 + hd * 512 + slice * 64 + (tid >> 3)) * 64 + (tid & 7) * 8); \
  } while (0)
#define ML_GATES(vb_)                                                                                          \
  do {                                                                                                         \
    float* vb = vec + (vb_) * 328;                                                                             \
    const int L = lane, pos = dir ? 63 - L : L;                                                                \
    float lf = fminf(g_f, 0.f) - log1pf(__expf(-fabsf(g_f)));                                                  \
    float bc = lf;                                                                                             \
    _Pragma("unroll") for (int o = 1; o < 64; o <<= 1) { float t = __shfl_up(bc, o); if (L >= o) bc += t; }    \
    float a = g_i - bc;                                                                                        \
    float cm = a;                                                                                              \
    _Pragma("unroll") for (int o = 1; o < 64; o <<= 1) { float t = __shfl_up(cm, o); if (L >= o) cm = fmaxf(cm, t); } \
    float c = fmaxf(m_st, cm);                                                                                 \
    float gtot = __shfl(bc, 63), c63 = __shfl(c, 63);                                                          \
    vb[pos] = a; vb[64 + pos] = c; vb[128 + pos] = __expf(m_st - c); vb[192 + pos] = __expf(-(c + bc));        \
    vb[256 + pos] = __expf(a - c63);                                                                           \
    if (L == 0) vb[320] = __expf(m_st - c63);                                                                  \
    m_st = gtot + c63;                                                                                         \
  } while (0)

  __syncthreads();
  ML_ISSUE(0);
  for (int i = tid; i < 64 * 264; i += 512) Cb[i] = 0;
  if (tid < 256) v_n[tid] = 0.f;
  f32x16 accC[2];
#pragma unroll
  for (int i = 0; i < 16; ++i) { accC[0][i] = 0.f; accC[1][i] = 0.f; }
  if (w == 0) ML_GATES(0);

  for (int st = 0; st < 64; ++st) {
    const int chunk = dir ? 63 - st : st;
    const size_t tok0 = (size_t)b * SEQ + chunk * 64;
    const float* v_a = vec + (st & 1) * 328, *v_c = v_a + 64, *v_wi = v_a + 128, *v_en = v_a + 192, *v_wk = v_a + 256,
               *v_sc = v_a + 320;
    __syncthreads();
#pragma unroll
    for (int i = 0; i < 4; ++i) {
      int idx = tid + 512 * i, row = idx >> 5, c16 = idx & 31;
      *(bf16x8*)(Qs + row * 264 + c16 * 8) = pq[i];
      *(bf16x8*)(Ks + row * 264 + c16 * 8) = pk[i];
    }
#pragma unroll
    for (int i = 0; i < 4; ++i) {
      int idx = tid + 512 * i, row = idx >> 3, c16 = idx & 7;
      *(bf16x8*)(Kt + row * 72 + c16 * 8) = pkt[i];
    }
    *(bf16x8*)(Vt + (tid >> 3) * 72 + (tid & 7) * 8) = pv;
    if (st + 1 < 64) ML_ISSUE(st + 1);
    __syncthreads();
    if (w < 4) {
      int jb = w >> 1, sb = w & 1;
      bool skip = dir ? (sb < jb) : (sb > jb);
      f32x16 sacc;
#pragma unroll
      for (int i = 0; i < 16; ++i) sacc[i] = 0.f;
      if (!skip) {
#pragma unroll 4
        for (int kk = 0; kk < 16; ++kk) {
          bf16x8 af = *(const bf16x8*)(Qs + (jb * 32 + r) * 264 + kk * 16 + h * 8);
          bf16x8 bfr = *(const bf16x8*)(Ks + (sb * 32 + r) * 264 + kk * 16 + h * 8);
          sacc = MFMA32(af, bfr, sacc);
        }
      }
      int s = sb * 32 + r;
      float as_ = v_a[s];
#pragma unroll
      for (int reg = 0; reg < 16; ++reg) {
        int j = jb * 32 + (reg & 3) + 8 * (reg >> 2) + 4 * h;
        bool valid = dir ? (s >= j) : (s <= j);
        float pv_ = (valid && !skip) ? sacc[reg] * __expf(as_ - v_c[j]) : 0.f;
        Ps[j * 72 + s] = f2bf(pv_);
      }
    } else {
      int t2 = tid - 256, j = t2 >> 2, part = t2 & 3;
      float sum = 0.f;
#pragma unroll
      for (int k8 = 0; k8 < 8; ++k8) {
        bf16x8 qv = *(const bf16x8*)(Qs + j * 264 + part * 64 + k8 * 8);
        float4 n0 = *(const float4*)(v_n + part * 64 + k8 * 8), n1 = *(const float4*)(v_n + part * 64 + k8 * 8 + 4);
        sum += bf2f((u16)qv[0]) * n0.x + bf2f((u16)qv[1]) * n0.y + bf2f((u16)qv[2]) * n0.z + bf2f((u16)qv[3]) * n0.w +
               bf2f((u16)qv[4]) * n1.x + bf2f((u16)qv[5]) * n1.y + bf2f((u16)qv[6]) * n1.z + bf2f((u16)qv[7]) * n1.w;
      }
      sum += __shfl_xor(sum, 1);
      sum += __shfl_xor(sum, 2);
      if (part == 0) v_qn[j] = sum;
    }
    __syncthreads();
    {
      int t = w & 3, jb = t >> 1, vb = t & 1, kh = w >> 2;
      f32x16 acc;
#pragma unroll
      for (int i = 0; i < 16; ++i) acc[i] = 0.f;
#pragma unroll 4
      for (int kk = kh * 8; kk < kh * 8 + 8; ++kk) {
        bf16x8 af = *(const bf16x8*)(Qs + (jb * 32 + r) * 264 + kk * 16 + h * 8);
        bf16x8 bfr = *(const bf16x8*)(Cb + (vb * 32 + r) * 264 + kk * 16 + h * 8);
        acc = MFMA32(af, bfr, acc);
      }
#pragma unroll
      for (int reg = 0; reg < 16; ++reg) acc[reg] *= v_wi[jb * 32 + (reg & 3) + 8 * (reg >> 2) + 4 * h];
#pragma unroll
      for (int ss = kh * 2; ss < kh * 2 + 2; ++ss) {
        bf16x8 af = *(const bf16x8*)(Ps + (jb * 32 + r) * 72 + ss * 16 + h * 8);
        bf16x8 bfr = *(const bf16x8*)(Vt + (vb * 32 + r) * 72 + ss * 16 + h * 8);
        acc = MFMA32(af, bfr, acc);
      }
      if (kh == 1) {
#pragma unroll
        for (int reg = 0; reg < 16; ++reg) Xch[t * 1024 + reg * 64 + lane] = acc[reg];
        int t2 = tid - 256, j = t2 >> 2, part = t2 & 3;
        float sum = 0.f;
#pragma unroll
        for (int k8 = 0; k8 < 2; ++k8) {
          bf16x8 pv_ = *(const bf16x8*)(Ps + j * 72 + part * 16 + k8 * 8);
#pragma unroll
          for (int e = 0; e < 8; ++e) sum += bf2f((u16)pv_[e]);
        }
        sum += __shfl_xor(sum, 1);
        sum += __shfl_xor(sum, 2);
        if (part == 0) v_den[j] = sum + v_wi[j] * v_qn[j];
      }
      __syncthreads();
      if (kh == 0) {
#pragma unroll
        for (int reg = 0; reg < 16; ++reg) {
          int j = jb * 32 + (reg & 3) + 8 * (reg >> 2) + 4 * h;
          float num = acc[reg] + Xch[t * 1024 + reg * 64 + lane];
          float dn = fmaxf(fabsf(v_den[j]), v_en[j]);
          hdst[(tok0 + j) * DM + hd * 512 + slice * 64 + vb * 32 + r] = f2bf(num / dn);
        }
      }
    }
    {
      int row = tid >> 3, c16 = tid & 7;
      bf16x8 vv = *(const bf16x8*)(Vt + row * 72 + c16 * 8);
      float4 w0 = *(const float4*)(v_wk + c16 * 8), w1 = *(const float4*)(v_wk + c16 * 8 + 4);
      vv[0] = (short)f2bf(bf2f((u16)vv[0]) * w0.x); vv[1] = (short)f2bf(bf2f((u16)vv[1]) * w0.y);
      vv[2] = (short)f2bf(bf2f((u16)vv[2]) * w0.z); vv[3] = (short)f2bf(bf2f((u16)vv[3]) * w0.w);
      vv[4] = (short)f2bf(bf2f((u16)vv[4]) * w1.x); vv[5] = (short)f2bf(bf2f((u16)vv[5]) * w1.y);
      vv[6] = (short)f2bf(bf2f((u16)vv[6]) * w1.z); vv[7] = (short)f2bf(bf2f((u16)vv[7]) * w1.w);
      *(bf16x8*)(Vt + row * 72 + c16 * 8) = vv;
      if (tid >= 256) {
        int k = tid - 256;
        float sum = v_sc[0] * v_n[k];
#pragma unroll
        for (int k8 = 0; k8 < 8; ++k8) {
          bf16x8 kv = *(const bf16x8*)(Kt + k * 72 + k8 * 8);
          float4 x0 = *(const float4*)(v_wk + k8 * 8), x1 = *(const float4*)(v_wk + k8 * 8 + 4);
          sum += bf2f((u16)kv[0]) * x0.x + bf2f((u16)kv[1]) * x0.y + bf2f((u16)kv[2]) * x0.z + bf2f((u16)kv[3]) * x0.w +
                 bf2f((u16)kv[4]) * x1.x + bf2f((u16)kv[5]) * x1.y + bf2f((u16)kv[6]) * x1.z + bf2f((u16)kv[7]) * x1.w;
        }
        v_n[k] = sum;
      }
      if (w == 0 && st + 1 < 64) ML_GATES((st + 1) & 1);
    }
    __syncthreads();
    {
      float decay = v_sc[0];
#pragma unroll
      for (int i = 0; i < 16; ++i) { accC[0][i] *= decay; accC[1][i] *= decay; }
#pragma unroll
      for (int ss = 0; ss < 4; ++ss) {
        bf16x8 af = *(const bf16x8*)(Kt + (32 * w + r) * 72 + ss * 16 + h * 8);
        bf16x8 b0 = *(const bf16x8*)(Vt + (r) * 72 + ss * 16 + h * 8);
        bf16x8 b1 = *(const bf16x8*)(Vt + (32 + r) * 72 + ss * 16 + h * 8);
        accC[0] = MFMA32(af, b0, accC[0]);
        accC[1] = MFMA32(af, b1, accC[1]);
      }
#pragma unroll
      for (int vb = 0; vb < 2; ++vb)
#pragma unroll
        for (int g = 0; g < 4; ++g) {
          u16x4 pk4 = {f2bf(accC[vb][4 * g]), f2bf(accC[vb][4 * g + 1]), f2bf(accC[vb][4 * g + 2]), f2bf(accC[vb][4 * g + 3])};
          *(u16x4*)(Cb + (vb * 32 + r) * 264 + 32 * w + 8 * g + 4 * h) = pk4;
        }
    }
  }
  __syncthreads();
#undef ML_ISSUE
#undef ML_GATES
}

template <int dir>
__device__ __forceinline__ void lru_item(const Params& p, int layer, int item, char* lds, int wave) {
  const int b = item >> 6, blk = (item >> 2) & 15, half = item & 1;
  const int lane = fresh_lane(), tid = wave * 64 + lane, w = wave, c = lane & 15, q = lane >> 4;
  const u16* xbp = (const u16*)(p.ws + WS_XBP);
  u16* hdst = (u16*)(p.ws + (dir ? WS_LHB : WS_LHF));
  __syncthreads();
  if (w >= 4) {
    const int t2 = tid - 256, cg = t2 & 15, tq = t2 >> 4;
    float cw[4][8], cbias[8];
#pragma unroll
    for (int e = 0; e < 8; ++e) {
      int ch = blk * 128 + cg * 8 + e;
      cbias[e] = p.conv_b[layer * DM + ch];
#pragma unroll
      for (int tap = 0; tap < 4; ++tap) cw[tap][e] = p.conv_w[(layer * 4 + tap) * DM + ch];
    }
    bf16x8 px[7];
#define LRU_LOAD(ti_)                                                                                      \
  do {                                                                                                     \
    const int s0_ = (dir ? 63 - (ti_) : (ti_)) * 64 + 4 * tq - 2;                                          \
    _Pragma("unroll") for (int rr = 0; rr < 7; ++rr) {                                                     \
      int sp_ = s0_ + rr;                                                                                  \
      bf16x8 z = {0, 0, 0, 0, 0, 0, 0, 0};                                                                 \
      px[rr] = (sp_ >= 0 && sp_ < SEQ) ? *(const bf16x8*)(xbp + ((size_t)b * SEQ + sp_) * DM + blk * 128 + cg * 8) : z; \
    }                                                                                                      \
  } while (0)
#define LRU_CONV(buf_)                                                                                     \
  do {                                                                                                     \
    u16* xcb = (u16*)(lds + (buf_) * 17408);                                                               \
    float* xcf = (float*)(lds + 34816 + (buf_) * 17408);                                                   \
    _Pragma("unroll") for (int tk = 0; tk < 4; ++tk) {                                                     \
      float xc[8];                                                                                         \
      _Pragma("unroll") for (int e = 0; e < 8; ++e) {                                                      \
        xc[e] = cbias[e] + cw[0][e] * bf2f((u16)px[tk][e]) + cw[1][e] * bf2f((u16)px[tk + 1][e]) +         \
                cw[2][e] * bf2f((u16)px[tk + 2][e]) + cw[3][e] * bf2f((u16)px[tk + 3][e]);                 \
      }                                                                                                    \
      bf16x8 o8;                                                                                           \
      _Pragma("unroll") for (int e = 0; e < 8; ++e) o8[e] = (short)f2bf(xc[e]);                            \
      const int tt = 4 * tq + tk;                                                                          \
      *(bf16x8*)(xcb + tt * 136 + cg * 8) = o8;                                                            \
      if ((cg >> 3) == half) {                                                                             \
        float* d = xcf + tt * 68 + (cg & 7) * 8;                                                           \
        *(float4*)d = make_float4(xc[0], xc[1], xc[2], xc[3]);                                             \
        *(float4*)(d + 4) = make_float4(xc[4], xc[5], xc[6], xc[7]);                                       \
      }                                                                                                    \
    }                                                                                                      \
  } while (0)
    LRU_LOAD(0);
    LRU_CONV(0);
    LRU_LOAD(1);
    __syncthreads();
    for (int ti = 0; ti < 64; ++ti) {
      if (ti + 1 < 64) {
        LRU_CONV((ti + 1) & 1);
        if (ti + 2 < 64) LRU_LOAD(ti + 2);
      }
      __syncthreads();
    }
#undef LRU_LOAD
#undef LRU_CONV
  } else {
    bf16x8 Br[4], Bi[4];
    const int chl = half * 64 + 16 * w + c, ch = blk * 128 + chl;
    const u16* wrg = (const u16*)(p.ws + WS_WSM + (size_t)layer * WSM_STRIDE + 24 * MiB);
    const u16* wr_ = wrg + ((size_t)((dir * 2 + 0) * 16 + blk)) * 16384 + chl * 128;
    const u16* wi_ = wrg + ((size_t)((dir * 2 + 1) * 16 + blk)) * 16384 + chl * 128;
#pragma unroll
    for (int kk = 0; kk < 4; ++kk) {
      Br[kk] = *(const bf16x8*)(wr_ + kk * 32 + q * 8);
      Bi[kk] = *(const bf16x8*)(wi_ + kk * 32 + q * 8);
    }
    const float br = p.b_rg[((layer * 2 + dir) * 2 + 0) * DM + ch];
    const float bi = p.b_rg[((layer * 2 + dir) * 2 + 1) * DM + ch];
    const float lam = p.lam[(layer * 2 + dir) * DM + ch];
    const float sp8 = -8.f * (fmaxf(-lam, 0.f) + log1pf(__expf(-fabsf(lam))));
    float carry = 0.f;
    __syncthreads();
    for (int ti = 0; ti < 64; ++ti) {
      const int tile = dir ? 63 - ti : ti, s0 = tile * 64;
      const u16* xcb = (const u16*)(lds + (ti & 1) * 17408);
      const float* xcf = (const float*)(lds + 34816 + (ti & 1) * 17408);
      f32x4 ar[4], ai_[4];
#pragma unroll
      for (int m = 0; m < 4; ++m) {
        ar[m] = f32x4{0.f, 0.f, 0.f, 0.f};
        ai_[m] = f32x4{0.f, 0.f, 0.f, 0.f};
#pragma unroll
        for (int kk = 0; kk < 4; ++kk) {
          bf16x8 af = *(const bf16x8*)(xcb + (16 * m + c) * 136 + kk * 32 + q * 8);
          ar[m] = MFMA16(af, Br[kk], ar[m]);
          ai_[m] = MFMA16(af, Bi[kk], ai_[m]);
        }
      }
#pragma unroll
      for (int mi = 0; mi < 4; ++mi) {
        const int m = dir ? 3 - mi : mi;
        float a_[4], u_[4];
#pragma unroll
        for (int i = 0; i < 4; ++i) {
          float rg = sigmoidf_(ar[m][i] + br), ig = sigmoidf_(ai_[m][i] + bi);
          float a = __expf(sp8 * rg);
          float xv = xcf[(16 * m + 4 * q + i) * 68 + 16 * w + c];
          a_[i] = a;
          u_[i] = sqrtf(fmaxf(1.f - a * a, 0.f)) * ig * xv;
        }
        float A4 = a_[0] * a_[1] * a_[2] * a_[3];
        float hv[4];
        if (!dir) {
          float U4 = ((u_[0] * a_[1] + u_[1]) * a_[2] + u_[2]) * a_[3] + u_[3];
          float hin = carry;
#pragma unroll
          for (int qq = 0; qq < 3; ++qq) {
            float Aq = __shfl(A4, qq * 16 + c), Uq = __shfl(U4, qq * 16 + c);
            if (qq < q) hin = Aq * hin + Uq;
          }
          hv[0] = a_[0] * hin + u_[0];
          hv[1] = a_[1] * hv[0] + u_[1];
          hv[2] = a_[2] * hv[1] + u_[2];
          hv[3] = a_[3] * hv[2] + u_[3];
          carry = __shfl(hv[3], 48 + c);
        } else {
          float U4 = ((u_[3] * a_[2] + u_[2]) * a_[1] + u_[1]) * a_[0] + u_[0];
          float hin = carry;
#pragma unroll
          for (int qq = 3; qq > 0; --qq) {
            float Aq = __shfl(A4, qq * 16 + c), Uq = __shfl(U4, qq * 16 + c);
            if (qq > q) hin = Aq * hin + Uq;
          }
          hv[3] = a_[3] * hin + u_[3];
          hv[2] = a_[2] * hv[3] + u_[2];
          hv[1] = a_[1] * hv[2] + u_[1];
          hv[0] = a_[0] * hv[1] + u_[0];
          carry = __shfl(hv[0], c);
        }
#pragma unroll
        for (int i = 0; i < 4; ++i)
          hdst[((size_t)b * SEQ + s0 + 16 * m + 4 * q + i) * DM + ch] = f2bf(hv[i]);
      }
      __syncthreads();
    }
  }
  __syncthreads();
}

__device__ __forceinline__ void phase_mixers(const Params& p, int layer, char* lds, int wave) {
  for (int it = blockIdx.x; it < 512; it += gridDim.x) {
    if (it < 256) {
      int j = it >> 3;
      mlstm_item(p, layer, (it & 7) * 4 + (j >> 3), j & 7, lds, wave);
    } else {
      if (((it - 256) >> 1) & 1) lru_item<1>(p, layer, it - 256, lds, wave);
      else lru_item<0>(p, layer, it - 256, lds, wave);
    }
  }
}

__device__ __forceinline__ void phase_post(const Params& p, int layer, int wave) {
  int lane = fresh_lane(), wid = wave;
  int gw = blockIdx.x * 8 + wid, nw = gridDim.x * 8;
  const u16* hf = (const u16*)(p.ws + WS_XB16);
  const u16* hb = (const u16*)(p.ws + WS_WT0);
  const u16* lf = (const u16*)(p.ws + WS_LHF);
  const u16* lb = (const u16*)(p.ws + WS_LHB);
  const u16* o = (const u16*)(p.ws + WS_O);
  u16* za = (u16*)(p.ws + WS_ZA);
  u16* zb = (u16*)(p.ws + WS_ZB);
  for (int wi = gw; wi < T * 4; wi += nw) {
    size_t off = (size_t)(wi >> 2) * DM + (wi & 3) * 512 + lane * 8;
    int col = (wi & 3) * 512 + lane * 8;
    bf16x8 f8 = *(const bf16x8*)(hf + off), b8 = *(const bf16x8*)(hb + off);
    bf16x8 o8 = *(const bf16x8*)(o + off), z8 = *(const bf16x8*)(za + off);
    bf16x8 lf8 = *(const bf16x8*)(lf + off), lb8 = *(const bf16x8*)(lb + off), zb8 = *(const bf16x8*)(zb + off);
    float hv[8], ss = 0.f;
#pragma unroll
    for (int e = 0; e < 8; ++e) { hv[e] = bf2f((u16)f8[e]) + bf2f((u16)b8[e]); ss += hv[e] * hv[e]; }
#pragma unroll
    for (int s = 32; s >= 1; s >>= 1) ss += __shfl_xor(ss, s);
    float rn = rsqrtf(ss * (1.f / 512.f) + EPS);
    const float* hg = p.head_g + layer * DM + col;
    bf16x8 ya, yb;
#pragma unroll
    for (int e = 0; e < 8; ++e) {
      float ov = bf2f((u16)o8[e]), zv = bf2f((u16)z8[e]);
      float y = hv[e] * rn * hg[e] * sigmoidf_(ov) * (zv * sigmoidf_(zv));
      ya[e] = (short)f2bf(y);
      float zbv = bf2f((u16)zb8[e]);
      float y2 = (bf2f((u16)lf8[e]) + bf2f((u16)lb8[e])) * (zbv * sigmoidf_(zbv));
      yb[e] = (short)f2bf(y2);
    }
    *(bf16x8*)(za + off) = ya;
    *(bf16x8*)(zb + off) = yb;
  }
}

constexpr int NPHASE = 13;
#define PH(n, code)                         \
  if (ph_lo <= (n) && (n) < ph_hi) {        \
    if ((n) > ph_lo) cg::this_grid().sync(); \
    code;                                   \
  }
__global__ void __launch_bounds__(512, 2) mega(Params p, int ph_lo, int ph_hi) {
  extern __shared__ __attribute__((aligned(16))) char lds[];
  const int wave = __builtin_amdgcn_readfirstlane(threadIdx.x >> 6);
  PH(0, { phase_convert(p, lds, wave); if (PROBE_DUP == 5) phase_convert(p, lds, wave); phase_rowpass(p, 0, p.x, wave); })
  PH(1, { phase_inproj(p, 0, lds, wave); if (PROBE_DUP == 1) { __syncthreads(); phase_inproj(p, 0, lds, wave); } })
  PH(2, { phase_mixers(p, 0, lds, wave);
          if (PROBE_DUP == 2) { int j = blockIdx.x >> 3; mlstm_item(p, 0, (blockIdx.x & 7) * 4 + (j >> 3), j & 7, lds, wave); }
          if (PROBE_DUP == 3) { if ((blockIdx.x >> 1) & 1) lru_item<1>(p, 0, blockIdx.x, lds, wave); else lru_item<0>(p, 0, blockIdx.x, lds, wave); } })
  PH(3, phase_post(p, 0, wave))
  PH(4, { phase_branch(p, 0, lds, wave); if (PROBE_DUP == 4) { __syncthreads(); phase_branch(p, 0, lds, wave); } })
  PH(5, phase_outproj(p, 0, lds, wave))
  PH(6, phase_rowpass(p, 1, p.out, wave))
  PH(7, phase_inproj(p, 1, lds, wave))
  PH(8, phase_mixers(p, 1, lds, wave))
  PH(9, phase_post(p, 1, wave))
  PH(10, phase_branch(p, 1, lds, wave))
  PH(11, phase_outproj(p, 1, lds, wave))
  PH(12, phase_final(p, wave))
}

extern "C" void kernel_launch(void* const* d_in, const int* in_sizes, int n_in, void* d_out, int out_size, void* d_ws,
                              size_t ws_size, hipStream_t stream) {
  static int grid = 0;
  if (grid == 0) {
    if (ws_size < WS_END) { fprintf(stderr, "workspace too small: %zu < %zu\n", ws_size, (size_t)WS_END); grid = -1; return; }
    int dev = 0, cus = 0, per_cu = 0;
    hipGetDevice(&dev);
    hipDeviceGetAttribute(&cus, hipDeviceAttributeMultiprocessorCount, dev);
    if (hipFuncSetAttribute((const void*)mega, hipFuncAttributeMaxDynamicSharedMemorySize, LDS_BYTES) != hipSuccess) {
      fprintf(stderr, "hipFuncSetAttribute failed\n"); grid = -1; return;
    }
    hipOccupancyMaxActiveBlocksPerMultiprocessor(&per_cu, (const void*)mega, 512, LDS_BYTES);
    if (per_cu < 1) { fprintf(stderr, "occupancy query says %d\n", per_cu); per_cu = 1; }
    (void)hipGetLastError();
    grid = cus * 1;
  }
  if (grid < 0) return;
  Params p{};
  p.x = (const float*)d_in[0]; p.norm_g = (const float*)d_in[1]; p.w_in = (const float*)d_in[2];
  p.b_if = (const float*)d_in[3]; p.head_g = (const float*)d_in[4]; p.conv_w = (const float*)d_in[5];
  p.conv_b = (const float*)d_in[6]; p.w_rg = (const float*)d_in[7]; p.b_rg = (const float*)d_in[8];
  p.lam = (const float*)d_in[9]; p.w_a = (const float*)d_in[10]; p.w_b = (const float*)d_in[11];
  p.w_o = (const float*)d_in[12]; p.final_g = (const float*)d_in[13];
  p.out = (float*)d_out; p.ws = (unsigned char*)d_ws;
#if COOP
  int lo = 0, hi = NPHASE;
  void* args[] = {&p, &lo, &hi};
  hipError_t e = hipLaunchCooperativeKernel((const void*)mega, dim3(grid), dim3(512), args, LDS_BYTES, stream);
  if (e != hipSuccess) fprintf(stderr, "cooperative launch failed: %s (grid %d)\n", hipGetErrorString(e), grid);
#else
  for (int ph = 0; ph < NPHASE; ++ph) hipLaunchKernelGGL(mega, dim3(grid), dim3(512), LDS_BYTES, stream, p, ph, ph + 1);
#endif
}
```

```cpp
#include <hip/hip_runtime.h>
#include <hip/hip_cooperative_groups.h>
#include <cstdio>
#include <cstdint>
namespace cg = cooperative_groups;

#ifndef PROBE_DUP
#define PROBE_DUP 0
#endif
#ifndef COOP
#define COOP 1
#endif

typedef unsigned short u16;
using bf16x8 = __attribute__((ext_vector_type(8))) short;
using u16x4 = __attribute__((ext_vector_type(4))) unsigned short;
using f32x4 = __attribute__((ext_vector_type(4))) float;
using f32x16 = __attribute__((ext_vector_type(16))) float;

constexpr int T = 16384, SEQ = 4096, DM = 2048, NIN = 16400;
constexpr float EPS = 1e-6f;
constexpr size_t MiB = 1ull << 20;
constexpr size_t WS_WT0 = 0;
constexpr size_t WS_WT1 = 64 * MiB;
constexpr size_t WS_WSM = 128 * MiB;
constexpr size_t WSM_STRIDE = 27 * MiB;
constexpr size_t WS_Q = 182 * MiB, WS_K = 214 * MiB, WS_KT = 246 * MiB, WS_VT = 278 * MiB, WS_O = 342 * MiB,
                 WS_ZA = 406 * MiB, WS_XBP = 470 * MiB, WS_ZB = 534 * MiB, WS_GA = 598 * MiB, WS_GB = 662 * MiB,
                 WS_XB16 = 726 * MiB,
                 WS_LHF = 790 * MiB, WS_LHB = 854 * MiB, WS_RS = 918 * MiB, WS_GATES = 918 * MiB + 65536,
                 WS_END = 920 * MiB;
constexpr int LDS_BYTES = 160 * 1024;

struct Params {
  const float *x, *norm_g, *w_in, *b_if, *head_g, *conv_w, *conv_b, *w_rg, *b_rg, *lam, *w_a, *w_b, *w_o, *final_g;
  float* out;
  unsigned char* ws;
};

__device__ __forceinline__ u16 f2bf(float f) {
  uint32_t u = __float_as_uint(f);
  u += 0x7fffu + ((u >> 16) & 1u);
  return (u16)(u >> 16);
}
__device__ __forceinline__ float bf2f(u16 h) { return __uint_as_float(((uint32_t)h) << 16); }
__device__ __forceinline__ int fresh_lane() {
  int l;
  asm volatile("v_mbcnt_lo_u32_b32 %0, -1, 0\n\tv_mbcnt_hi_u32_b32 %0, -1, %0" : "=v"(l));
  return l & 63;
}
#define TID_DECL const int tid = wave * 64 + fresh_lane()
__device__ __forceinline__ float sigmoidf_(float x) { return 1.f / (1.f + __expf(-x)); }

__device__ __forceinline__ void tconv_tile(const float* __restrict__ src, long ld_src, int k0, int n0s, u16* __restrict__ dst,
                           long ld_dst, int n0d, const float* __restrict__ rowscale, float cs, float* tile, int wave) {
  TID_DECL;
  int c = tid & 63, r = tid >> 6;
#pragma unroll
  for (int i = 0; i < 8; ++i) {
    int kl = r + 8 * i;
    float v = src[(long)(k0 + kl) * ld_src + n0s + c];
    if (rowscale) v *= rowscale[k0 + kl];
    tile[kl * 65 + c] = v * cs;
  }
  __syncthreads();
#pragma unroll
  for (int i = 0; i < 8; ++i) {
    int nl = r + 8 * i;
    dst[(long)(n0d + nl) * ld_dst + k0 + c] = f2bf(tile[c * 65 + nl]);
  }
  __syncthreads();
}

__device__ __forceinline__ void phase_convert(const Params& p, char* lds, int wave) {
  TID_DECL;
  float* tile = (float*)lds;
  constexpr int PER_LAYER = 8192 + 3072 + 256 + 1;
  for (int it = blockIdx.x; it < 2 * PER_LAYER; it += gridDim.x) {
    int l = it / PER_LAYER, r = it % PER_LAYER;
    unsigned char* wsm = p.ws + WS_WSM + (size_t)l * WSM_STRIDE;
    if (r < 8192) {
      int kt = r & 31, nt = r >> 5;
      int n0d = nt * 64, n0s = n0d < 8192 ? n0d : n0d + 16;
      float cs = (n0d >= 1024 && n0d < 2048) ? 0.0625f : 1.f;
      u16* dst = (u16*)(p.ws + (l ? WS_WT1 : WS_WT0));
      tconv_tile(p.w_in + (size_t)l * DM * NIN, NIN, kt * 64, n0s, dst, DM, n0d, p.norm_g + l * DM, cs, tile, wave);
    } else if (r < 8192 + 3072) {
      int q = r - 8192, which = q >> 10, tt = q & 1023, kt = tt & 31, nt = tt >> 5;
      const float* src = (which == 0 ? p.w_a : which == 1 ? p.w_b : p.w_o) + (size_t)l * DM * DM;
      u16* dst = (u16*)(wsm + (size_t)which * 8 * MiB);
      tconv_tile(src, DM, kt * 64, nt * 64, dst, DM, nt * 64, nullptr, 1.f, tile, wave);
    } else if (r < 8192 + 3072 + 256) {
      int q = r - 8192 - 3072, mat = q >> 2, tt = q & 3;
      const float* src = p.w_rg + ((size_t)l * 64 + mat) * 16384;
      u16* dst = (u16*)(wsm + 24 * MiB) + (size_t)mat * 16384;
      tconv_tile(src, 128, (tt & 1) * 64, (tt >> 1) * 64, dst, 128, (tt >> 1) * 64, nullptr, 1.f, tile, wave);
    } else {
      u16* dst = (u16*)(wsm + 26 * MiB);
      const float* src = p.w_in + (size_t)l * DM * NIN;
      for (int i = tid; i < 16 * DM; i += 512) {
        int j = i >> 11, k = i & 2047;
        dst[i] = f2bf(src[(size_t)k * NIN + 8192 + j] * p.norm_g[l * DM + k]);
      }
    }
  }
}

__device__ __forceinline__ void phase_rowpass(const Params& p, int layer, const float* __restrict__ xin, int wave) {
  int lane = fresh_lane(), wid = wave;
  int gw = blockIdx.x * 8 + wid, nw = gridDim.x * 8;
  int r = lane & 15, q = lane >> 4;
  u16* xb16 = (u16*)(p.ws + WS_XB16);
  float* rs = (float*)(p.ws + WS_RS);
  float* gates = (float*)(p.ws + WS_GATES);
  const u16* wg = (const u16*)(p.ws + WS_WSM + (size_t)layer * WSM_STRIDE + 26 * MiB);
  for (int rt = gw; rt < T / 16; rt += nw) {
    int row = rt * 16 + r;
    const float* xr = xin + (size_t)row * DM + q * 8;
    f32x4 acc = {0.f, 0.f, 0.f, 0.f};
    float ss = 0.f;
#pragma unroll 4
    for (int kk = 0; kk < 64; ++kk) {
      float4 a0 = *(const float4*)(xr + kk * 32);
      float4 a1 = *(const float4*)(xr + kk * 32 + 4);
      ss += a0.x * a0.x + a0.y * a0.y + a0.z * a0.z + a0.w * a0.w + a1.x * a1.x + a1.y * a1.y + a1.z * a1.z + a1.w * a1.w;
      bf16x8 af;
      af[0] = (short)f2bf(a0.x); af[1] = (short)f2bf(a0.y); af[2] = (short)f2bf(a0.z); af[3] = (short)f2bf(a0.w);
      af[4] = (short)f2bf(a1.x); af[5] = (short)f2bf(a1.y); af[6] = (short)f2bf(a1.z); af[7] = (short)f2bf(a1.w);
      *(bf16x8*)(xb16 + (size_t)row * DM + kk * 32 + q * 8) = af;
      bf16x8 bfr = *(const bf16x8*)(wg + (size_t)r * DM + kk * 32 + q * 8);
      acc = __builtin_amdgcn_mfma_f32_16x16x32_bf16(af, bfr, acc, 0, 0, 0);
    }
    ss += __shfl_xor(ss, 16);
    ss += __shfl_xor(ss, 32);
    float rsv = rsqrtf(ss * (1.f / DM) + EPS);
    if (q == 0) rs[row] = rsv;
    float bias = p.b_if[layer * 16 + r];
#pragma unroll
    for (int j = 0; j < 4; ++j) {
      float rr = __shfl(rsv, q * 4 + j);
      gates[(size_t)(rt * 16 + q * 4 + j) * 16 + r] = acc[j] * rr + bias;
    }
  }
}

__device__ __forceinline__ void phase_final(const Params& p, int wave) {
  int lane = fresh_lane(), wid = wave;
  int gw = blockIdx.x * 8 + wid, nw = gridDim.x * 8;
  for (int row = gw; row < T; row += nw) {
    float* xr = p.out + (size_t)row * DM;
    float4 v[8];
    float ss = 0.f;
#pragma unroll
    for (int i = 0; i < 8; ++i) {
      v[i] = *(const float4*)(xr + i * 256 + lane * 4);
      ss += v[i].x * v[i].x + v[i].y * v[i].y + v[i].z * v[i].z + v[i].w * v[i].w;
    }
#pragma unroll
    for (int o = 32; o >= 1; o >>= 1) ss += __shfl_xor(ss, o);
    float rsv = rsqrtf(ss * (1.f / DM) + EPS);
#pragma unroll
    for (int i = 0; i < 8; ++i) {
      float4 g = *(const float4*)(p.final_g + i * 256 + lane * 4);
      float4 o4;
      o4.x = v[i].x * rsv * g.x; o4.y = v[i].y * rsv * g.y; o4.z = v[i].z * rsv * g.z; o4.w = v[i].w * rsv * g.w;
      *(float4*)(xr + i * 256 + lane * 4) = o4;
    }
  }
}

#define LAS __attribute__((address_space(3)))
constexpr int BM = 256, BK = 64, HALF = 128, HTB = HALF * BK * 2, GK = 2048;
typedef unsigned u32x4 __attribute__((ext_vector_type(4)));
typedef f32x4 acc_t[2][2][4][2];
__device__ __forceinline__ int lds_byte(int r, int c) {
  const int st = (r >> 4) * 2 + (c >> 5), rr = r & 15, cc = c & 31, ob = rr * 64 + cc * 2;
  return st * 1024 + (ob ^ (((ob >> 9) & 1) << 5));
}
__device__ __forceinline__ void stage_rc(int b, int& R, int& C) {
  const int st = b / 1024, sb = b % 1024, swz = sb ^ (((sb >> 9) & 1) << 5);
  R = (st >> 1) * 16 + swz / 64;
  C = (st & 1) * 32 + (swz % 64) / 2;
}
__device__ __forceinline__ int perm32(int rho) { const int n = rho >> 4, i = rho & 15; return 8 * (i >> 2) + 4 * n + (i & 3); }
__device__ __forceinline__ unsigned cvt_pk_bf16(float lo, float hi) {
  unsigned r;
  asm volatile("v_cvt_pk_bf16_f32 %0, %1, %2" : "=v"(r) : "v"(lo), "v"(hi));
  return r;
}
struct Unit { int pm, pn, aux; const char* A; const char* B; };

__device__ __forceinline__ void tile_map(int wgid, int nM, int nN, int& pm, int& pn) {
  int nwg = nM * nN;
  int q = nwg / 8, r = nwg % 8, xcd = wgid % 8, off = wgid / 8;
  wgid = (xcd < r ? xcd * (q + 1) : r * (q + 1) + (xcd - r) * q) + off;
  int nig = 8 * nN, gid = wgid / nig, fm = gid * 8, gsz = min(nM - fm, 8);
  pm = fm + ((wgid % nig) % gsz);
  pn = (wgid % nig) / gsz;
}

template <class Epi, class Sched>
__device__ __forceinline__ void gemm_stream(char* lds_, const Sched& S, const Epi& E, int wave) {
  LAS unsigned char* lds = (LAS unsigned char*)lds_;
  const int lane = fresh_lane(), tid = wave * 64 + lane, wid = wave, wr = wid >> 2, wc = wid & 3, fr = lane & 15, fq = lane >> 4;
  constexpr int K = GK, nt = K / BK;
  unsigned voffA[2], voffB[2];
#pragma unroll
  for (int i = 0; i < 2; ++i) {
    int R, C;
    stage_rc(tid * 16 + i * 8192, R, C);
    const int Rb = Epi::PERM ? ((R & ~31) + perm32(R & 31)) : R;
    voffA[i] = (unsigned)(R * K + C) * 2u;
    voffB[i] = (unsigned)(Rb * K + C) * 2u;
  }
  constexpr size_t kstep = (size_t)(BK * 2), hstep = (size_t)HALF * K * 2;
  const unsigned ldsw = (unsigned)wid * 1024u;
  const int aoff = lds_byte(wr * 64 + fr, fq * 8), boff = lds_byte(wc * 32 + fr, fq * 8);
#define G_SA(b, h) (((b) * 2 + (h)) * HTB)
#define G_SB(b, h) ((4 + (b) * 2 + (h)) * HTB)
#define G_STAGE(bufoff, gbase, voff)                                                                               \
  do {                                                                                                             \
    _Pragma("unroll") for (int _i = 0; _i < 2; ++_i) __builtin_amdgcn_global_load_lds(                             \
        (const unsigned*)((const char*)(gbase) + (voff)[_i]), (LAS unsigned*)(lds + (bufoff) + ldsw + _i * 8192), 16, 0, 0); \
  } while (0)
#define G_LDA(dst, b, h)                                                                                           \
  do {                                                                                                             \
    _Pragma("unroll") for (int m = 0; m < 4; ++m) _Pragma("unroll") for (int k = 0; k < 2; ++k) dst[m][k] =        \
        *(const LAS bf16x8*)(lds + G_SA(b, h) + aoff + m * 2048 + k * 1024);                                       \
  } while (0)
#define G_LDB(dst, b, h)                                                                                           \
  do {                                                                                                             \
    _Pragma("unroll") for (int n = 0; n < 2; ++n) _Pragma("unroll") for (int k = 0; k < 2; ++k) dst[n][k] =        \
        *(const LAS bf16x8*)(lds + G_SB(b, h) + boff + n * 2048 + k * 1024);                                       \
  } while (0)
#define G_MMA(ai, bj, At_, Bt_)                                                                                    \
  do {                                                                                                             \
    __builtin_amdgcn_s_setprio(1);                                                                                 \
    _Pragma("unroll") for (int m = 0; m < 4; ++m) _Pragma("unroll") for (int n = 0; n < 2; ++n)                    \
        _Pragma("unroll") for (int k = 0; k < 2; ++k) acc[ai][bj][m][n] =                                          \
            __builtin_amdgcn_mfma_f32_16x16x32_bf16(Bt_[n][k], At_[m][k], acc[ai][bj][m][n], 0, 0, 0);            \
    __builtin_amdgcn_s_setprio(0);                                                                                 \
  } while (0)
#define G_WAIT_V(n) asm volatile("s_waitcnt vmcnt(" #n ")" ::: "memory")
#define G_WAIT_L(n) asm volatile("s_waitcnt lgkmcnt(" #n ")" ::: "memory")
#define G_BAR __builtin_amdgcn_s_barrier()
#define G_SCHED __builtin_amdgcn_sched_barrier(0)
#define G_ZERO_ACC()                                                                                               \
  do {                                                                                                             \
    _Pragma("unroll") for (int a = 0; a < 2; ++a) _Pragma("unroll") for (int b = 0; b < 2; ++b)                    \
        _Pragma("unroll") for (int m = 0; m < 4; ++m) _Pragma("unroll") for (int n = 0; n < 2; ++n)                \
            acc[a][b][m][n] = (f32x4){0.f, 0.f, 0.f, 0.f};                                                         \
  } while (0)
  Unit cur, nxt;
  int ui = 0;
  if (!S.next(0, cur)) return;
  acc_t acc;
  G_ZERO_ACC();
  bf16x8 At[4][2], B0[2][2], B1[2][2];
  const char* cA = cur.A;
  const char* cB = cur.B;
  G_STAGE(G_SB(0, 0), cB, voffB); G_STAGE(G_SA(0, 0), cA, voffA); G_STAGE(G_SB(0, 1), cB + hstep, voffB); G_STAGE(G_SA(0, 1), cA + hstep, voffA);
  if (wr == 1) G_BAR;
  G_WAIT_V(4); G_BAR;
  G_STAGE(G_SB(1, 0), cB + kstep, voffB); G_STAGE(G_SA(1, 0), cA + kstep, voffA); G_STAGE(G_SB(1, 1), cB + hstep + kstep, voffB);
  G_WAIT_V(6); G_BAR;
  for (;;) {
    const bool has_next = S.next(ui + 1, nxt);
    const char* nA = has_next ? nxt.A : cA;
    const char* nB = has_next ? nxt.B : cB;
    for (int t = 0; t < nt; t += 2) {
      const bool last = (t == nt - 2);
      const char* a1 = cA + (size_t)(t + 1) * kstep;
      const char* a2 = last ? nA : cA + (size_t)(t + 2) * kstep;
      const char* b2 = last ? nB : cB + (size_t)(t + 2) * kstep;
      const char* a3 = a2 + kstep;
      const char* b3 = b2 + kstep;
      G_LDB(B0, 0, 0); G_SCHED; G_LDA(At, 0, 0); G_STAGE(G_SA(1, 1), a1 + hstep, voffA);
      G_WAIT_L(8); G_BAR; G_WAIT_L(0); G_MMA(0, 0, At, B0); G_BAR; G_SCHED;
      G_LDB(B1, 0, 1); G_STAGE(G_SB(0, 0), b2, voffB);
      G_BAR; G_WAIT_L(0); G_MMA(0, 1, At, B1); G_BAR;
      G_LDA(At, 0, 1); G_STAGE(G_SA(0, 0), a2, voffA);
      G_BAR; G_WAIT_L(0); G_MMA(1, 0, At, B0); G_BAR; G_SCHED;
      G_STAGE(G_SB(0, 1), b2 + hstep, voffB);
      G_WAIT_V(6); G_BAR; G_MMA(1, 1, At, B1); G_BAR;
      G_LDB(B0, 1, 0); G_SCHED; G_LDA(At, 1, 0); G_STAGE(G_SA(0, 1), a2 + hstep, voffA);
      G_WAIT_L(8); G_BAR; G_WAIT_L(0); G_MMA(0, 0, At, B0); G_BAR; G_SCHED;
      G_LDB(B1, 1, 1); G_STAGE(G_SB(1, 0), b3, voffB);
      G_BAR; G_WAIT_L(0); G_MMA(0, 1, At, B1); G_BAR;
      G_LDA(At, 1, 1); G_STAGE(G_SA(1, 0), a3, voffA);
      G_BAR; G_WAIT_L(0); G_MMA(1, 0, At, B0); G_BAR; G_SCHED;
      G_STAGE(G_SB(1, 1), b3 + hstep, voffB);
      G_WAIT_V(6); G_BAR; G_MMA(1, 1, At, B1); G_BAR;
    }
    const bool zero = E(acc, cur, wr, wc, fr, fq);
    if (!has_next) break;
    if (zero) G_ZERO_ACC();
    cur = nxt; cA = nA; cB = nB; ++ui;
  }
  G_WAIT_V(0);
  if (wr == 0) G_BAR;
  G_BAR;
#undef G_SA
#undef G_SB
#undef G_STAGE
#undef G_LDA
#undef G_LDB
#undef G_MMA
}

struct SchedIn {
  const char* A; const char* B; int G, c;
  __device__ __forceinline__ bool next(int i, Unit& u) const {
    const int L = i * G + c;
    if (L >= 64 * 64) return false;
    tile_map(L, 64, 64, u.pm, u.pn);
    u.aux = 0;
    u.A = A + (size_t)u.pm * 256 * GK * 2;
    u.B = B + (size_t)u.pn * 256 * GK * 2;
    return true;
  }
};
struct EpiIn {
  static constexpr bool PERM = true;
  unsigned char* ws; const float* rs;
  __device__ __forceinline__ bool operator()(const acc_t& acc, const Unit& u, int wr, int wc, int fr, int fq) const {
    const int bcol = u.pn * 256;
    const int seg = bcol < 1024 ? 0 : bcol < 2048 ? 1 : bcol < 4096 ? 2 : 3 + (bcol - 4096) / 2048;
    const int cbase = seg == 0 ? 0 : seg == 1 ? 1024 : seg == 2 ? 2048 : 4096 + (seg - 3) * 2048;
    const int w = seg < 2 ? 1024 : 2048;
    const size_t off_rm = seg == 0 ? WS_Q : seg == 1 ? WS_K : seg == 3 ? WS_O : seg == 4 ? WS_ZA : seg == 5 ? WS_XBP
                        : seg == 6 ? WS_ZB : seg == 7 ? WS_GA : WS_GB;
    const int row0 = u.pm * 256 + wr * 64 + fr, col0 = bcol - cbase + wc * 32 + 8 * fq;
    u16* dst_rm = (u16*)(ws + off_rm);
    u16* dst_t = (u16*)(ws + (seg == 1 ? WS_KT : WS_VT));
#pragma unroll
    for (int ai = 0; ai < 2; ++ai)
#pragma unroll
      for (int m = 0; m < 4; ++m) {
        const int row = row0 + ai * HALF + m * 16;
        const float sc = rs[row];
#pragma unroll
        for (int bj = 0; bj < 2; ++bj) {
          f32x4 v0 = acc[ai][bj][m][0] * sc, v1 = acc[ai][bj][m][1] * sc;
          u32x4 wv;
          wv.x = cvt_pk_bf16(v0[0], v0[1]); wv.y = cvt_pk_bf16(v0[2], v0[3]);
          wv.z = cvt_pk_bf16(v1[0], v1[1]); wv.w = cvt_pk_bf16(v1[2], v1[3]);
          const int col = col0 + bj * HALF;
          if (seg != 2) *(u32x4*)(dst_rm + (size_t)row * w + col) = wv;
          if (seg == 1 || seg == 2) {
            u16* d = dst_t + ((size_t)(row >> 6) * w + col) * 64 + (row & 63);
            d[0] = (u16)(wv.x & 0xffff); d[64] = (u16)(wv.x >> 16); d[128] = (u16)(wv.y & 0xffff); d[192] = (u16)(wv.y >> 16);
            d[256] = (u16)(wv.z & 0xffff); d[320] = (u16)(wv.z >> 16); d[384] = (u16)(wv.w & 0xffff); d[448] = (u16)(wv.w >> 16);
          }
        }
        __builtin_amdgcn_sched_barrier(0);
      }
    return true;
  }
};
__device__ __forceinline__ void phase_inproj(const Params& p, int layer, char* lds, int wave) {
  SchedIn S{(const char*)(p.ws + WS_XB16), (const char*)(p.ws + (layer ? WS_WT1 : WS_WT0)), (int)gridDim.x, (int)blockIdx.x};
  EpiIn E{p.ws, (const float*)(p.ws + WS_RS)};
  gemm_stream(lds, S, E, wave);
}

struct SchedBr {
  const char *YA, *YB, *WA, *WB; int G, c;
  __device__ __forceinline__ bool next(int i, Unit& u) const {
    const int L = (i >> 1) * G + c;
    if (L >= 64 * 8) return false;
    tile_map(L, 64, 8, u.pm, u.pn);
    u.aux = i & 1;
    u.A = (u.aux ? YA : YB) + (size_t)u.pm * 256 * GK * 2;
    u.B = (u.aux ? WA : WB) + (size_t)u.pn * 256 * GK * 2;
    return true;
  }
};
struct EpiBr {
  static constexpr bool PERM = true;
  const u16 *GA, *GB; u16* MG;
  __device__ __forceinline__ bool operator()(acc_t& acc, const Unit& u, int wr, int wc, int fr, int fq) const {
    const int row0 = u.pm * 256 + wr * 64 + fr, col0 = u.pn * 256 + wc * 32 + 8 * fq;
#pragma unroll
    for (int ai = 0; ai < 2; ++ai)
#pragma unroll
      for (int m = 0; m < 4; ++m) {
#pragma unroll
        for (int bj = 0; bj < 2; ++bj) {
          const size_t idx = (size_t)(row0 + ai * HALF + m * 16) * DM + col0 + bj * HALF;
          bf16x8 ga = *(const bf16x8*)(GA + idx);
          if (u.aux == 0) {
            bf16x8 gb = *(const bf16x8*)(GB + idx);
#pragma unroll
            for (int e = 0; e < 8; ++e) {
              float ea = __expf(-bf2f((u16)ga[e])), eb = __expf(-bf2f((u16)gb[e]));
              acc[ai][bj][m][e >> 2][e & 3] *= (1.f + ea) * __builtin_amdgcn_rcpf(1.f + eb);
            }
          } else {
            float o[8];
#pragma unroll
            for (int e = 0; e < 8; ++e) o[e] = acc[ai][bj][m][e >> 2][e & 3] * __builtin_amdgcn_rcpf(1.f + __expf(-bf2f((u16)ga[e])));
            u32x4 wv;
            wv.x = cvt_pk_bf16(o[0], o[1]); wv.y = cvt_pk_bf16(o[2], o[3]); wv.z = cvt_pk_bf16(o[4], o[5]); wv.w = cvt_pk_bf16(o[6], o[7]);
            *(u32x4*)(MG + idx) = wv;
          }
        }
        __builtin_amdgcn_sched_barrier(0);
      }
    return u.aux != 0;
  }
};
__device__ __forceinline__ void phase_branch(const Params& p, int layer, char* lds, int wave) {
  const char* wsm = (const char*)(p.ws + WS_WSM + (size_t)layer * WSM_STRIDE);
  SchedBr S{(const char*)(p.ws + WS_ZA), (const char*)(p.ws + WS_ZB), wsm, wsm + 8 * MiB, (int)gridDim.x, (int)blockIdx.x};
  EpiBr E{(const u16*)(p.ws + WS_GA), (const u16*)(p.ws + WS_GB), (u16*)(p.ws + WS_O)};
  gemm_stream(lds, S, E, wave);
}

struct SchedOut {
  const char *A, *B; int G, c;
  __device__ __forceinline__ bool next(int i, Unit& u) const {
    const int L = i * G + c;
    if (L >= 64 * 8) return false;
    tile_map(L, 64, 8, u.pm, u.pn);
    u.aux = 0;
    u.A = A + (size_t)u.pm * 256 * GK * 2;
    u.B = B + (size_t)u.pn * 256 * GK * 2;
    return true;
  }
};
struct EpiOut {
  static constexpr bool PERM = false;
  const float* xres; float* out;
  __device__ __forceinline__ bool operator()(const acc_t& acc, const Unit& u, int wr, int wc, int fr, int fq) const {
    const int row0 = u.pm * 256 + wr * 64 + fr, col0 = u.pn * 256 + wc * 32 + 4 * fq;
#pragma unroll
    for (int ai = 0; ai < 2; ++ai)
#pragma unroll
      for (int m = 0; m < 4; ++m) {
        const size_t rb = (size_t)(row0 + ai * HALF + m * 16) * DM + col0;
#pragma unroll
        for (int bj = 0; bj < 2; ++bj)
#pragma unroll
          for (int n = 0; n < 2; ++n) {
            const size_t idx = rb + bj * HALF + n * 16;
            f32x4 xv = *(const f32x4*)(xres + idx);
            *(f32x4*)(out + idx) = xv + acc[ai][bj][m][n];
          }
        __builtin_amdgcn_sched_barrier(0);
      }
    return true;
  }
};
__device__ __forceinline__ void phase_outproj(const Params& p, int layer, char* lds, int wave) {
  SchedOut S{(const char*)(p.ws + WS_O), (const char*)(p.ws + WS_WSM + (size_t)layer * WSM_STRIDE + 16 * MiB), (int)gridDim.x, (int)blockIdx.x};
  EpiOut E{layer == 0 ? p.x : p.out, p.out};
  gemm_stream(lds, S, E, wave);
}

#define MFMA32(a, b, c) __builtin_amdgcn_mfma_f32_32x32x16_bf16(a, b, c, 0, 0, 0)
#define MFMA16(a, b, c) __builtin_amdgcn_mfma_f32_16x16x32_bf16(a, b, c, 0, 0, 0)

__device__ __forceinline__ void mlstm_item(const Params& p, int layer, int grp, int slice, char* lds, int wave) {
  const int b = grp >> 3, hd = (grp >> 1) & 3, dir = grp & 1;
  const int lane = fresh_lane(), tid = wave * 64 + lane, w = wave, r = lane & 31, h = lane >> 5;
  u16* Qs = (u16*)lds;
  u16* Ks = Qs + 64 * 264;
  u16* Kt = Ks + 64 * 264;
  u16* Vt = Kt + 256 * 72;
  u16* Ps = Vt + 64 * 72;
  u16* Cb = Ps + 64 * 72;
  float* vec = (float*)(Cb + 64 * 264);
  float* v_qn = vec + 656, *v_den = vec + 720, *v_n = vec + 784;
  float* Xch = (float*)Ks;
  const u16* gq = (const u16*)(p.ws + WS_Q);
  const u16* gk = (const u16*)(p.ws + WS_K);
  const u16* gkt = (const u16*)(p.ws + WS_KT);
  const u16* gvt = (const u16*)(p.ws + WS_VT);
  const float* gates = (const float*)(p.ws + WS_GATES);
  u16* hdst = (u16*)(p.ws + (dir ? WS_WT0 : WS_XB16));

  bf16x8 pq[4], pk[4], pkt[4], pv;
  float g_i = 0.f, g_f = 0.f, m_st = 0.f;
  const int gw = dir ? 2 : 1;
#define ML_ISSUE(st_)                                                                                          \
  do {                                                                                                         \
    const int chunk_ = dir ? 63 - (st_) : (st_);                                                               \
    const size_t tok_ = (size_t)b * SEQ + chunk_ * 64;                                                         \
    if (w == gw) {                                                                                             \
      const float* gp = gates + (tok_ + (dir ? 63 - lane : lane)) * 16;                                        \
      g_i = gp[dir * 4 + hd];                                                                                  \
      g_f = gp[8 + dir * 4 + hd];                                                                              \
    }                                                                                                          \
    _Pragma("unroll") for (int i = 0; i < 4; ++i) {                                                            \
      int idx = tid + 512 * i, row = idx >> 5, c16 = idx & 31;                                                 \
      pq[i] = *(const bf16x8*)(gq + (tok_ + row) * 1024 + hd * 256 + c16 * 8);                                 \
      pk[i] = *(const bf16x8*)(gk + (tok_ + row) * 1024 + hd * 256 + c16 * 8);                                 \
    }                                                                                                          \
    _Pragma("unroll") for (int i = 0; i < 4; ++i) {                                                            \
      int idx = tid + 512 * i, row = idx >> 3, c16 = idx & 7;                                                  \
      pkt[i] = *(const bf16x8*)(gkt + ((tok_ >> 6) * 1024 + hd * 256 + row) * 64 + c16 * 8);                   \
    }                                                                                                          \
    pv = *(const bf16x8*)(gvt + ((tok_ >> 6) * 2048 + hd * 512 + slice * 64 + (tid >> 3)) * 64 + (tid & 7) * 8); \
  } while (0)
#define ML_GATES(vb_)                                                                                          \
  do {                                                                                                         \
    float* vb = vec + (vb_) * 328;                                                                             \
    const int L = lane, pos = dir ? 63 - L : L;                                                                \
    float lf = fminf(g_f, 0.f) - log1pf(__expf(-fabsf(g_f)));                                                  \
    float bc = lf;                                                                                             \
    _Pragma("unroll") for (int o = 1; o < 64; o <<= 1) { float t = __shfl_up(bc, o); if (L >= o) bc += t; }    \
    float a = g_i - bc;                                                                                        \
    float cm = a;                                                                                              \
    _Pragma("unroll") for (int o = 1; o < 64; o <<= 1) { float t = __shfl_up(cm, o); if (L >= o) cm = fmaxf(cm, t); } \
    float c = fmaxf(m_st, cm);                                                                                 \
    float gtot = __shfl(bc, 63), c63 = __shfl(c, 63);                                                          \
    vb[pos] = a; vb[64 + pos] = c; vb[128 + pos] = __expf(m_st - c); vb[192 + pos] = __expf(-(c + bc));        \
    vb[256 + pos] = __expf(a - c63);                                                                           \
    if (L == 0) vb[320] = __expf(m_st - c63);                                                                  \
    m_st = gtot + c63;                                                                                         \
  } while (0)

  __syncthreads();
  ML_ISSUE(0);
  for (int i = tid; i < 64 * 264; i += 512) Cb[i] = 0;
  if (tid < 256) v_n[tid] = 0.f;
  f32x16 accC[2];
#pragma unroll
  for (int i = 0; i < 16; ++i) { accC[0][i] = 0.f; accC[1][i] = 0.f; }
  if (w == gw) ML_GATES(0);

  for (int st = 0; st < 64; ++st) {
    const int chunk = dir ? 63 - st : st;
    const size_t tok0 = (size_t)b * SEQ + chunk * 64;
    const float* v_a = vec + (st & 1) * 328, *v_c = v_a + 64, *v_wi = v_a + 128, *v_en = v_a + 192, *v_wk = v_a + 256,
               *v_sc = v_a + 320;
    __syncthreads();
#pragma unroll
    for (int i = 0; i < 4; ++i) {
      int idx = tid + 512 * i, row = idx >> 5, c16 = idx & 31;
      *(bf16x8*)(Qs + row * 264 + c16 * 8) = pq[i];
      *(bf16x8*)(Ks + row * 264 + c16 * 8) = pk[i];
    }
#pragma unroll
    for (int i = 0; i < 4; ++i) {
      int idx = tid + 512 * i, row = idx >> 3, c16 = idx & 7;
      *(bf16x8*)(Kt + row * 72 + c16 * 8) = pkt[i];
    }
    *(bf16x8*)(Vt + (tid >> 3) * 72 + (tid & 7) * 8) = pv;
    if (st + 1 < 64) ML_ISSUE(st + 1);
    __syncthreads();
    if (w < 4) {
      int jb = w >> 1, sb = w & 1;
      bool skip = dir ? (sb < jb) : (sb > jb);
      f32x16 sacc;
#pragma unroll
      for (int i = 0; i < 16; ++i) sacc[i] = 0.f;
      if (!skip) {
#pragma unroll 4
        for (int kk = 0; kk < 16; ++kk) {
          bf16x8 af = *(const bf16x8*)(Qs + (jb * 32 + r) * 264 + kk * 16 + h * 8);
          bf16x8 bfr = *(const bf16x8*)(Ks + (sb * 32 + r) * 264 + kk * 16 + h * 8);
          sacc = MFMA32(af, bfr, sacc);
        }
      }
      int s = sb * 32 + r;
      float as_ = v_a[s];
#pragma unroll
      for (int reg = 0; reg < 16; ++reg) {
        int j = jb * 32 + (reg & 3) + 8 * (reg >> 2) + 4 * h;
        bool valid = dir ? (s >= j) : (s <= j);
        float pv_ = (valid && !skip) ? sacc[reg] * __expf(as_ - v_c[j]) : 0.f;
        Ps[j * 72 + s] = f2bf(pv_);
      }
      if (w == gw && st + 1 < 64) ML_GATES((st + 1) & 1);
    } else {
      int t2 = tid - 256, j = t2 >> 2, part = t2 & 3;
      float sum = 0.f;
#pragma unroll
      for (int k8 = 0; k8 < 8; ++k8) {
        bf16x8 qv = *(const bf16x8*)(Qs + j * 264 + part * 64 + k8 * 8);
        float4 n0 = *(const float4*)(v_n + part * 64 + k8 * 8), n1 = *(const float4*)(v_n + part * 64 + k8 * 8 + 4);
        sum += bf2f((u16)qv[0]) * n0.x + bf2f((u16)qv[1]) * n0.y + bf2f((u16)qv[2]) * n0.z + bf2f((u16)qv[3]) * n0.w +
               bf2f((u16)qv[4]) * n1.x + bf2f((u16)qv[5]) * n1.y + bf2f((u16)qv[6]) * n1.z + bf2f((u16)qv[7]) * n1.w;
      }
      sum += __shfl_xor(sum, 1);
      sum += __shfl_xor(sum, 2);
      if (part == 0) v_qn[j] = sum;
    }
    __syncthreads();
    {
      int t = w & 3, jb = t >> 1, vb = t & 1, kh = w >> 2;
      f32x16 acc;
#pragma unroll
      for (int i = 0; i < 16; ++i) acc[i] = 0.f;
#pragma unroll 4
      for (int kk = kh * 8; kk < kh * 8 + 8; ++kk) {
        bf16x8 af = *(const bf16x8*)(Qs + (jb * 32 + r) * 264 + kk * 16 + h * 8);
        bf16x8 bfr = *(const bf16x8*)(Cb + (vb * 32 + r) * 264 + kk * 16 + h * 8);
        acc = MFMA32(af, bfr, acc);
      }
#pragma unroll
      for (int reg = 0; reg < 16; ++reg) acc[reg] *= v_wi[jb * 32 + (reg & 3) + 8 * (reg >> 2) + 4 * h];
#pragma unroll
      for (int ss = kh * 2; ss < kh * 2 + 2; ++ss) {
        bf16x8 af = *(const bf16x8*)(Ps + (jb * 32 + r) * 72 + ss * 16 + h * 8);
        bf16x8 bfr = *(const bf16x8*)(Vt + (vb * 32 + r) * 72 + ss * 16 + h * 8);
        acc = MFMA32(af, bfr, acc);
      }
      if (kh == 1) {
#pragma unroll
        for (int reg = 0; reg < 16; ++reg) Xch[t * 1024 + reg * 64 + lane] = acc[reg];
        int t2 = tid - 256, j = t2 >> 2, part = t2 & 3;
        float sum = 0.f;
#pragma unroll
        for (int k8 = 0; k8 < 2; ++k8) {
          bf16x8 pv_ = *(const bf16x8*)(Ps + j * 72 + part * 16 + k8 * 8);
#pragma unroll
          for (int e = 0; e < 8; ++e) sum += bf2f((u16)pv_[e]);
        }
        sum += __shfl_xor(sum, 1);
        sum += __shfl_xor(sum, 2);
        if (part == 0) v_den[j] = sum + v_wi[j] * v_qn[j];
      }
      __syncthreads();
      if (kh == 0) {
#pragma unroll
        for (int reg = 0; reg < 16; ++reg) {
          int j = jb * 32 + (reg & 3) + 8 * (reg >> 2) + 4 * h;
          float num = acc[reg] + Xch[t * 1024 + reg * 64 + lane];
          float dn = fmaxf(fabsf(v_den[j]), v_en[j]);
          hdst[(tok0 + j) * DM + hd * 512 + slice * 64 + vb * 32 + r] = f2bf(num * __builtin_amdgcn_rcpf(dn));
        }
      }
    }
    {
      int row = tid >> 3, c16 = tid & 7;
      bf16x8 vv = *(const bf16x8*)(Vt + row * 72 + c16 * 8);
      float4 w0 = *(const float4*)(v_wk + c16 * 8), w1 = *(const float4*)(v_wk + c16 * 8 + 4);
      vv[0] = (short)f2bf(bf2f((u16)vv[0]) * w0.x); vv[1] = (short)f2bf(bf2f((u16)vv[1]) * w0.y);
      vv[2] = (short)f2bf(bf2f((u16)vv[2]) * w0.z); vv[3] = (short)f2bf(bf2f((u16)vv[3]) * w0.w);
      vv[4] = (short)f2bf(bf2f((u16)vv[4]) * w1.x); vv[5] = (short)f2bf(bf2f((u16)vv[5]) * w1.y);
      vv[6] = (short)f2bf(bf2f((u16)vv[6]) * w1.z); vv[7] = (short)f2bf(bf2f((u16)vv[7]) * w1.w);
      *(bf16x8*)(Vt + row * 72 + c16 * 8) = vv;
      if (tid >= 256) {
        int k = tid - 256;
        float sum = v_sc[0] * v_n[k];
#pragma unroll
        for (int k8 = 0; k8 < 8; ++k8) {
          bf16x8 kv = *(const bf16x8*)(Kt + k * 72 + k8 * 8);
          float4 x0 = *(const float4*)(v_wk + k8 * 8), x1 = *(const float4*)(v_wk + k8 * 8 + 4);
          sum += bf2f((u16)kv[0]) * x0.x + bf2f((u16)kv[1]) * x0.y + bf2f((u16)kv[2]) * x0.z + bf2f((u16)kv[3]) * x0.w +
                 bf2f((u16)kv[4]) * x1.x + bf2f((u16)kv[5]) * x1.y + bf2f((u16)kv[6]) * x1.z + bf2f((u16)kv[7]) * x1.w;
        }
        v_n[k] = sum;
      }
    }
    __syncthreads();
    {
      float decay = v_sc[0];
#pragma unroll
      for (int i = 0; i < 16; ++i) { accC[0][i] *= decay; accC[1][i] *= decay; }
#pragma unroll
      for (int ss = 0; ss < 4; ++ss) {
        bf16x8 af = *(const bf16x8*)(Kt + (32 * w + r) * 72 + ss * 16 + h * 8);
        bf16x8 b0 = *(const bf16x8*)(Vt + (r) * 72 + ss * 16 + h * 8);
        bf16x8 b1 = *(const bf16x8*)(Vt + (32 + r) * 72 + ss * 16 + h * 8);
        accC[0] = MFMA32(af, b0, accC[0]);
        accC[1] = MFMA32(af, b1, accC[1]);
      }
#pragma unroll
      for (int vb = 0; vb < 2; ++vb)
#pragma unroll
        for (int g = 0; g < 4; ++g) {
          u16x4 pk4 = {f2bf(accC[vb][4 * g]), f2bf(accC[vb][4 * g + 1]), f2bf(accC[vb][4 * g + 2]), f2bf(accC[vb][4 * g + 3])};
          *(u16x4*)(Cb + (vb * 32 + r) * 264 + 32 * w + 8 * g + 4 * h) = pk4;
        }
    }
  }
  __syncthreads();
#undef ML_ISSUE
#undef ML_GATES
}

template <int dir>
__device__ __forceinline__ void lru_item(const Params& p, int layer, int item, char* lds, int wave) {
  const int b = item >> 6, blk = (item >> 2) & 15, half = item & 1;
  const int lane = fresh_lane(), tid = wave * 64 + lane, w = wave, c = lane & 15, q = lane >> 4;
  const u16* xbp = (const u16*)(p.ws + WS_XBP);
  u16* hdst = (u16*)(p.ws + (dir ? WS_LHB : WS_LHF));
  __syncthreads();
  if (w >= 4) {
    const int t2 = tid - 256, cg = t2 & 15, tq = t2 >> 4;
    float cw[4][8], cbias[8];
#pragma unroll
    for (int e = 0; e < 8; ++e) {
      int ch = blk * 128 + cg * 8 + e;
      cbias[e] = p.conv_b[layer * DM + ch];
#pragma unroll
      for (int tap = 0; tap < 4; ++tap) cw[tap][e] = p.conv_w[(layer * 4 + tap) * DM + ch];
    }
    bf16x8 px[7];
#define LRU_LOAD(ti_)                                                                                      \
  do {                                                                                                     \
    const int s0_ = (dir ? 63 - (ti_) : (ti_)) * 64 + 4 * tq - 2;                                          \
    _Pragma("unroll") for (int rr = 0; rr < 7; ++rr) {                                                     \
      int sp_ = s0_ + rr;                                                                                  \
      bf16x8 z = {0, 0, 0, 0, 0, 0, 0, 0};                                                                 \
      px[rr] = (sp_ >= 0 && sp_ < SEQ) ? *(const bf16x8*)(xbp + ((size_t)b * SEQ + sp_) * DM + blk * 128 + cg * 8) : z; \
    }                                                                                                      \
  } while (0)
#define LRU_CONV(buf_)                                                                                     \
  do {                                                                                                     \
    u16* xcb = (u16*)(lds + (buf_) * 17408);                                                               \
    float* xcf = (float*)(lds + 34816 + (buf_) * 17408);                                                   \
    _Pragma("unroll") for (int tk = 0; tk < 4; ++tk) {                                                     \
      float xc[8];                                                                                         \
      _Pragma("unroll") for (int e = 0; e < 8; ++e) {                                                      \
        xc[e] = cbias[e] + cw[0][e] * bf2f((u16)px[tk][e]) + cw[1][e] * bf2f((u16)px[tk + 1][e]) +         \
                cw[2][e] * bf2f((u16)px[tk + 2][e]) + cw[3][e] * bf2f((u16)px[tk + 3][e]);                 \
      }                                                                                                    \
      bf16x8 o8;                                                                                           \
      _Pragma("unroll") for (int e = 0; e < 8; ++e) o8[e] = (short)f2bf(xc[e]);                            \
      const int tt = 4 * tq + tk;                                                                          \
      *(bf16x8*)(xcb + tt * 136 + cg * 8) = o8;                                                            \
      if ((cg >> 3) == half) {                                                                             \
        float* d = xcf + tt * 68 + (cg & 7) * 8;                                                           \
        *(float4*)d = make_float4(xc[0], xc[1], xc[2], xc[3]);                                             \
        *(float4*)(d + 4) = make_float4(xc[4], xc[5], xc[6], xc[7]);                                       \
      }                                                                                                    \
    }                                                                                                      \
  } while (0)
    LRU_LOAD(0);
    LRU_CONV(0);
    LRU_LOAD(1);
    __syncthreads();
    for (int ti = 0; ti < 64; ++ti) {
      if (ti + 1 < 64) {
        LRU_CONV((ti + 1) & 1);
        if (ti + 2 < 64) LRU_LOAD(ti + 2);
      }
      __syncthreads();
    }
#undef LRU_LOAD
#undef LRU_CONV
  } else {
    bf16x8 Br[4], Bi[4];
    const int chl = half * 64 + 16 * w + c, ch = blk * 128 + chl;
    const u16* wrg = (const u16*)(p.ws + WS_WSM + (size_t)layer * WSM_STRIDE + 24 * MiB);
    const u16* wr_ = wrg + ((size_t)((dir * 2 + 0) * 16 + blk)) * 16384 + chl * 128;
    const u16* wi_ = wrg + ((size_t)((dir * 2 + 1) * 16 + blk)) * 16384 + chl * 128;
#pragma unroll
    for (int kk = 0; kk < 4; ++kk) {
      Br[kk] = *(const bf16x8*)(wr_ + kk * 32 + q * 8);
      Bi[kk] = *(const bf16x8*)(wi_ + kk * 32 + q * 8);
    }
    const float br = p.b_rg[((layer * 2 + dir) * 2 + 0) * DM + ch];
    const float bi = p.b_rg[((layer * 2 + dir) * 2 + 1) * DM + ch];
    const float lam = p.lam[(layer * 2 + dir) * DM + ch];
    const float sp8 = -8.f * (fmaxf(-lam, 0.f) + log1pf(__expf(-fabsf(lam))));
    float carry = 0.f;
    __syncthreads();
    for (int ti = 0; ti < 64; ++ti) {
      const int tile = dir ? 63 - ti : ti, s0 = tile * 64;
      const u16* xcb = (const u16*)(lds + (ti & 1) * 17408);
      const float* xcf = (const float*)(lds + 34816 + (ti & 1) * 17408);
      f32x4 ar[4], ai_[4];
#pragma unroll
      for (int m = 0; m < 4; ++m) {
        ar[m] = f32x4{0.f, 0.f, 0.f, 0.f};
        ai_[m] = f32x4{0.f, 0.f, 0.f, 0.f};
#pragma unroll
        for (int kk = 0; kk < 4; ++kk) {
          bf16x8 af = *(const bf16x8*)(xcb + (16 * m + c) * 136 + kk * 32 + q * 8);
          ar[m] = MFMA16(af, Br[kk], ar[m]);
          ai_[m] = MFMA16(af, Bi[kk], ai_[m]);
        }
      }
#pragma unroll
      for (int mi = 0; mi < 4; ++mi) {
        const int m = dir ? 3 - mi : mi;
        float a_[4], u_[4];
#pragma unroll
        for (int i = 0; i < 4; ++i) {
          float rg = sigmoidf_(ar[m][i] + br), ig = sigmoidf_(ai_[m][i] + bi);
          float a = __expf(sp8 * rg);
          float xv = xcf[(16 * m + 4 * q + i) * 68 + 16 * w + c];
          a_[i] = a;
          u_[i] = sqrtf(fmaxf(1.f - a * a, 0.f)) * ig * xv;
        }
        float A4 = a_[0] * a_[1] * a_[2] * a_[3];
        float hv[4];
        if (!dir) {
          float U4 = ((u_[0] * a_[1] + u_[1]) * a_[2] + u_[2]) * a_[3] + u_[3];
          float hin = carry;
#pragma unroll
          for (int qq = 0; qq < 3; ++qq) {
            float Aq = __shfl(A4, qq * 16 + c), Uq = __shfl(U4, qq * 16 + c);
            if (qq < q) hin = Aq * hin + Uq;
          }
          hv[0] = a_[0] * hin + u_[0];
          hv[1] = a_[1] * hv[0] + u_[1];
          hv[2] = a_[2] * hv[1] + u_[2];
          hv[3] = a_[3] * hv[2] + u_[3];
          carry = __shfl(hv[3], 48 + c);
        } else {
          float U4 = ((u_[3] * a_[2] + u_[2]) * a_[1] + u_[1]) * a_[0] + u_[0];
          float hin = carry;
#pragma unroll
          for (int qq = 3; qq > 0; --qq) {
            float Aq = __shfl(A4, qq * 16 + c), Uq = __shfl(U4, qq * 16 + c);
            if (qq > q) hin = Aq * hin + Uq;
          }
          hv[3] = a_[3] * hin + u_[3];
          hv[2] = a_[2] * hv[3] + u_[2];
          hv[1] = a_[1] * hv[2] + u_[1];
          hv[0] = a_[0] * hv[1] + u_[0];
          carry = __shfl(hv[0], c);
        }
#pragma unroll
        for (int i = 0; i < 4; ++i)
          hdst[((size_t)b * SEQ + s0 + 16 * m + 4 * q + i) * DM + ch] = f2bf(hv[i]);
      }
      __syncthreads();
    }
  }
  __syncthreads();
}

__device__ __forceinline__ void phase_mixers(const Params& p, int layer, char* lds, int wave) {
  for (int it = blockIdx.x; it < 512; it += gridDim.x) {
    if (it < 256) {
      int j = it >> 3;
      mlstm_item(p, layer, (it & 7) * 4 + (j >> 3), j & 7, lds, wave);
    } else {
      if (((it - 256) >> 1) & 1) lru_item<1>(p, layer, it - 256, lds, wave);
      else lru_item<0>(p, layer, it - 256, lds, wave);
    }
  }
}

__device__ __forceinline__ void phase_post(const Params& p, int layer, int wave) {
  int lane = fresh_lane(), wid = wave;
  int gw = blockIdx.x * 8 + wid, nw = gridDim.x * 8;
  const u16* hf = (const u16*)(p.ws + WS_XB16);
  const u16* hb = (const u16*)(p.ws + WS_WT0);
  const u16* lf = (const u16*)(p.ws + WS_LHF);
  const u16* lb = (const u16*)(p.ws + WS_LHB);
  const u16* o = (const u16*)(p.ws + WS_O);
  u16* za = (u16*)(p.ws + WS_ZA);
  u16* zb = (u16*)(p.ws + WS_ZB);
  for (int wi = gw; wi < T * 4; wi += nw) {
    size_t off = (size_t)(wi >> 2) * DM + (wi & 3) * 512 + lane * 8;
    int col = (wi & 3) * 512 + lane * 8;
    bf16x8 f8 = *(const bf16x8*)(hf + off), b8 = *(const bf16x8*)(hb + off);
    bf16x8 o8 = *(const bf16x8*)(o + off), z8 = *(const bf16x8*)(za + off);
    bf16x8 lf8 = *(const bf16x8*)(lf + off), lb8 = *(const bf16x8*)(lb + off), zb8 = *(const bf16x8*)(zb + off);
    float hv[8], ss = 0.f;
#pragma unroll
    for (int e = 0; e < 8; ++e) { hv[e] = bf2f((u16)f8[e]) + bf2f((u16)b8[e]); ss += hv[e] * hv[e]; }
#pragma unroll
    for (int s = 32; s >= 1; s >>= 1) ss += __shfl_xor(ss, s);
    float rn = rsqrtf(ss * (1.f / 512.f) + EPS);
    const float* hg = p.head_g + layer * DM + col;
    bf16x8 ya, yb;
#pragma unroll
    for (int e = 0; e < 8; ++e) {
      float ov = bf2f((u16)o8[e]), zv = bf2f((u16)z8[e]);
      float y = hv[e] * rn * hg[e] * sigmoidf_(ov) * (zv * sigmoidf_(zv));
      ya[e] = (short)f2bf(y);
      float zbv = bf2f((u16)zb8[e]);
      float y2 = (bf2f((u16)lf8[e]) + bf2f((u16)lb8[e])) * (zbv * sigmoidf_(zbv));
      yb[e] = (short)f2bf(y2);
    }
    *(bf16x8*)(za + off) = ya;
    *(bf16x8*)(zb + off) = yb;
  }
}

constexpr int NPHASE = 13;
#define PH(n, code)                         \
  if (ph_lo <= (n) && (n) < ph_hi) {        \
    if ((n) > ph_lo) cg::this_grid().sync(); \
    code;                                   \
  }
__global__ void __launch_bounds__(512, 2) mega(Params p, int ph_lo, int ph_hi) {
  extern __shared__ __attribute__((aligned(16))) char lds[];
  const int wave = __builtin_amdgcn_readfirstlane(threadIdx.x >> 6);
  PH(0, { phase_convert(p, lds, wave); if (PROBE_DUP == 5) phase_convert(p, lds, wave); phase_rowpass(p, 0, p.x, wave); })
  PH(1, { phase_inproj(p, 0, lds, wave); if (PROBE_DUP == 1) { __syncthreads(); phase_inproj(p, 0, lds, wave); } })
  PH(2, { phase_mixers(p, 0, lds, wave);
          if (PROBE_DUP == 2) { int j = blockIdx.x >> 3; mlstm_item(p, 0, (blockIdx.x & 7) * 4 + (j >> 3), j & 7, lds, wave); }
          if (PROBE_DUP == 3) { if ((blockIdx.x >> 1) & 1) lru_item<1>(p, 0, blockIdx.x, lds, wave); else lru_item<0>(p, 0, blockIdx.x, lds, wave); } })
  PH(3, phase_post(p, 0, wave))
  PH(4, { phase_branch(p, 0, lds, wave); if (PROBE_DUP == 4) { __syncthreads(); phase_branch(p, 0, lds, wave); } })
  PH(5, phase_outproj(p, 0, lds, wave))
  PH(6, phase_rowpass(p, 1, p.out, wave))
  PH(7, phase_inproj(p, 1, lds, wave))
  PH(8, phase_mixers(p, 1, lds, wave))
  PH(9, phase_post(p, 1, wave))
  PH(10, phase_branch(p, 1, lds, wave))
  PH(11, phase_outproj(p, 1, lds, wave))
  PH(12, phase_final(p, wave))
}

extern "C" void kernel_launch(void* const* d_in, const int* in_sizes, int n_in, void* d_out, int out_size, void* d_ws,
                              size_t ws_size, hipStream_t stream) {
  static int grid = 0;
  if (grid == 0) {
    if (ws_size < WS_END) { fprintf(stderr, "workspace too small: %zu < %zu\n", ws_size, (size_t)WS_END); grid = -1; return; }
    int dev = 0, cus = 0, per_cu = 0;
    hipGetDevice(&dev);
    hipDeviceGetAttribute(&cus, hipDeviceAttributeMultiprocessorCount, dev);
    if (hipFuncSetAttribute((const void*)mega, hipFuncAttributeMaxDynamicSharedMemorySize, LDS_BYTES) != hipSuccess) {
      fprintf(stderr, "hipFuncSetAttribute failed\n"); grid = -1; return;
    }
    hipOccupancyMaxActiveBlocksPerMultiprocessor(&per_cu, (const void*)mega, 512, LDS_BYTES);
    if (per_cu < 1) { fprintf(stderr, "occupancy query says %d\n", per_cu); per_cu = 1; }
    (void)hipGetLastError();
    grid = cus * 1;
  }
  if (grid < 0) return;
  Params p{};
  p.x = (const float*)d_in[0]; p.norm_g = (const float*)d_in[1]; p.w_in = (const float*)d_in[2];
  p.b_if = (const float*)d_in[3]; p.head_g = (const float*)d_in[4]; p.conv_w = (const float*)d_in[5];
  p.conv_b = (const float*)d_in[6]; p.w_rg = (const float*)d_in[7]; p.b_rg = (const float*)d_in[8];
  p.lam = (const float*)d_in[9]; p.w_a = (const float*)d_in[10]; p.w_b = (const float*)d_in[11];
  p.w_o = (const float*)d_in[12]; p.final_g = (const float*)d_in[13];
  p.out = (float*)d_out; p.ws = (unsigned char*)d_ws;
#if COOP
  int lo = 0, hi = NPHASE;
  void* args[] = {&p, &lo, &hi};
  hipError_t e = hipLaunchCooperativeKernel((const void*)mega, dim3(grid), dim3(512), args, LDS_BYTES, stream);
  if (e != hipSuccess) fprintf(stderr, "cooperative launch failed: %s (grid %d)\n", hipGetErrorString(e), grid);
#else
  for (int ph = 0; ph < NPHASE; ++ph) hipLaunchKernelGGL(mega, dim3(grid), dim3(512), LDS_BYTES, stream, p, ph, ph + 1);
#endif
}
```

```cpp
#include <hip/hip_runtime.h>
#include <hip/hip_cooperative_groups.h>
#include <cstdio>
#include <cstdint>
namespace cg = cooperative_groups;

#ifndef PROBE_DUP
#define PROBE_DUP 0
#endif
#ifndef COOP
#define COOP 1
#endif

typedef unsigned short u16;
using bf16x8 = __attribute__((ext_vector_type(8))) short;
using u16x4 = __attribute__((ext_vector_type(4))) unsigned short;
using f32x4 = __attribute__((ext_vector_type(4))) float;
using f32x16 = __attribute__((ext_vector_type(16))) float;

constexpr int T = 16384, SEQ = 4096, DM = 2048, NIN = 16400;
constexpr float EPS = 1e-6f;
constexpr size_t MiB = 1ull << 20;
constexpr size_t WS_WT0 = 0;
constexpr size_t WS_WT1 = 64 * MiB;
constexpr size_t WS_WSM = 128 * MiB;
constexpr size_t WSM_STRIDE = 27 * MiB;
constexpr size_t WS_Q = 182 * MiB, WS_K = 214 * MiB, WS_KT = 246 * MiB, WS_VT = 278 * MiB, WS_O = 342 * MiB,
                 WS_ZA = 406 * MiB, WS_XBP = 470 * MiB, WS_ZB = 534 * MiB, WS_GA = 598 * MiB, WS_GB = 662 * MiB,
                 WS_XB16 = 726 * MiB,
                 WS_LHF = 790 * MiB, WS_LHB = 854 * MiB, WS_RS = 918 * MiB, WS_GATES = 918 * MiB + 65536,
                 WS_END = 920 * MiB;
constexpr int LDS_BYTES = 160 * 1024;

struct Params {
  const float *x, *norm_g, *w_in, *b_if, *head_g, *conv_w, *conv_b, *w_rg, *b_rg, *lam, *w_a, *w_b, *w_o, *final_g;
  float* out;
  unsigned char* ws;
};

__device__ __forceinline__ u16 f2bf(float f) {
  uint32_t u = __float_as_uint(f);
  u += 0x7fffu + ((u >> 16) & 1u);
  return (u16)(u >> 16);
}
typedef unsigned u32x4 __attribute__((ext_vector_type(4)));
__device__ __forceinline__ unsigned cvt_pk_bf16(float lo, float hi) {
  unsigned r;
  asm volatile("v_cvt_pk_bf16_f32 %0, %1, %2" : "=v"(r) : "v"(lo), "v"(hi));
  return r;
}
__device__ __forceinline__ float bf2f(u16 h) { return __uint_as_float(((uint32_t)h) << 16); }
__device__ __forceinline__ int fresh_lane() {
  int l;
  asm volatile("v_mbcnt_lo_u32_b32 %0, -1, 0\n\tv_mbcnt_hi_u32_b32 %0, -1, %0" : "=v"(l));
  return l & 63;
}
#define TID_DECL const int tid = wave * 64 + fresh_lane()
__device__ __forceinline__ float sigmoidf_(float x) { return 1.f / (1.f + __expf(-x)); }

__device__ __forceinline__ void tconv_tile(const float* __restrict__ src, long ld_src, int k0, int n0s, u16* __restrict__ dst,
                           long ld_dst, int n0d, const float* __restrict__ rowscale, float cs, float* tile, int wave) {
  TID_DECL;
  {
    const int c4 = tid & 31, r = tid >> 5;
#pragma unroll
    for (int i = 0; i < 8; ++i) {
      int kl = r + 16 * i;
      float4 v = *(const float4*)(src + (long)(k0 + kl) * ld_src + n0s + c4 * 4);
      float sc = cs * (rowscale ? rowscale[k0 + kl] : 1.f);
      float* t = tile + kl * 129 + c4 * 4;
      t[0] = v.x * sc; t[1] = v.y * sc; t[2] = v.z * sc; t[3] = v.w * sc;
    }
  }
  __syncthreads();
#pragma unroll
  for (int i = 0; i < 4; ++i) {
    const int id = tid + 512 * i, nl = id >> 4, kc = id & 15;
    const float* t = tile + (kc * 8) * 129 + nl;
    u32x4 wv;
    wv.x = cvt_pk_bf16(t[0], t[129]);
    wv.y = cvt_pk_bf16(t[2 * 129], t[3 * 129]);
    wv.z = cvt_pk_bf16(t[4 * 129], t[5 * 129]);
    wv.w = cvt_pk_bf16(t[6 * 129], t[7 * 129]);
    *(u32x4*)(dst + (long)(n0d + nl) * ld_dst + k0 + kc * 8) = wv;
  }
  __syncthreads();
}

__device__ __forceinline__ void phase_convert(const Params& p, char* lds, int wave) {
  TID_DECL;
  float* tile = (float*)lds;
  constexpr int PER_LAYER = 2048 + 768 + 64 + 1;
  for (int it = blockIdx.x; it < 2 * PER_LAYER; it += gridDim.x) {
    int l = it / PER_LAYER, r = it % PER_LAYER;
    unsigned char* wsm = p.ws + WS_WSM + (size_t)l * WSM_STRIDE;
    if (r < 2048) {
      int kt = r & 15, nt = r >> 4;
      int n0d = nt * 128, n0s = n0d < 8192 ? n0d : n0d + 16;
      float cs = (n0d >= 1024 && n0d < 2048) ? 0.0625f : 1.f;
      u16* dst = (u16*)(p.ws + (l ? WS_WT1 : WS_WT0));
      tconv_tile(p.w_in + (size_t)l * DM * NIN, NIN, kt * 128, n0s, dst, DM, n0d, p.norm_g + l * DM, cs, tile, wave);
    } else if (r < 2048 + 768) {
      int q = r - 2048, which = q >> 8, tt = q & 255, kt = tt & 15, nt = tt >> 4;
      const float* src = (which == 0 ? p.w_a : which == 1 ? p.w_b : p.w_o) + (size_t)l * DM * DM;
      u16* dst = (u16*)(wsm + (size_t)which * 8 * MiB);
      tconv_tile(src, DM, kt * 128, nt * 128, dst, DM, nt * 128, nullptr, 1.f, tile, wave);
    } else if (r < 2048 + 768 + 64) {
      int mat = r - 2048 - 768;
      const float* src = p.w_rg + ((size_t)l * 64 + mat) * 16384;
      u16* dst = (u16*)(wsm + 24 * MiB) + (size_t)mat * 16384;
      tconv_tile(src, 128, 0, 0, dst, 128, 0, nullptr, 1.f, tile, wave);
    } else {
      u16* dst = (u16*)(wsm + 26 * MiB);
      const float* src = p.w_in + (size_t)l * DM * NIN;
      for (int i = tid; i < 16 * DM; i += 512) {
        int j = i >> 11, k = i & 2047;
        dst[i] = f2bf(src[(size_t)k * NIN + 8192 + j] * p.norm_g[l * DM + k]);
      }
    }
  }
}

__device__ __forceinline__ void phase_rowpass(const Params& p, int layer, const float* __restrict__ xin, int wave) {
  int lane = fresh_lane(), wid = wave;
  int gw = blockIdx.x * 8 + wid, nw = gridDim.x * 8;
  int r = lane & 15, q = lane >> 4;
  u16* xb16 = (u16*)(p.ws + WS_XB16);
  float* rs = (float*)(p.ws + WS_RS);
  float* gates = (float*)(p.ws + WS_GATES);
  const u16* wg = (const u16*)(p.ws + WS_WSM + (size_t)layer * WSM_STRIDE + 26 * MiB);
  for (int rt = gw; rt < T / 16; rt += nw) {
    int row = rt * 16 + r;
    const float* xr = xin + (size_t)row * DM + q * 8;
    f32x4 acc = {0.f, 0.f, 0.f, 0.f};
    float ss = 0.f;
#pragma unroll 4
    for (int kk = 0; kk < 64; ++kk) {
      float4 a0 = *(const float4*)(xr + kk * 32);
      float4 a1 = *(const float4*)(xr + kk * 32 + 4);
      ss += a0.x * a0.x + a0.y * a0.y + a0.z * a0.z + a0.w * a0.w + a1.x * a1.x + a1.y * a1.y + a1.z * a1.z + a1.w * a1.w;
      bf16x8 af;
      af[0] = (short)f2bf(a0.x); af[1] = (short)f2bf(a0.y); af[2] = (short)f2bf(a0.z); af[3] = (short)f2bf(a0.w);
      af[4] = (short)f2bf(a1.x); af[5] = (short)f2bf(a1.y); af[6] = (short)f2bf(a1.z); af[7] = (short)f2bf(a1.w);
      *(bf16x8*)(xb16 + (size_t)row * DM + kk * 32 + q * 8) = af;
      bf16x8 bfr = *(const bf16x8*)(wg + (size_t)r * DM + kk * 32 + q * 8);
      acc = __builtin_amdgcn_mfma_f32_16x16x32_bf16(af, bfr, acc, 0, 0, 0);
    }
    ss += __shfl_xor(ss, 16);
    ss += __shfl_xor(ss, 32);
    float rsv = rsqrtf(ss * (1.f / DM) + EPS);
    if (q == 0) rs[row] = rsv;
    float bias = p.b_if[layer * 16 + r];
#pragma unroll
    for (int j = 0; j < 4; ++j) {
      float rr = __shfl(rsv, q * 4 + j);
      gates[(size_t)(rt * 16 + q * 4 + j) * 16 + r] = acc[j] * rr + bias;
    }
  }
}

__device__ __forceinline__ void phase_final(const Params& p, int wave) {
  int lane = fresh_lane(), wid = wave;
  int gw = blockIdx.x * 8 + wid, nw = gridDim.x * 8;
  for (int row = gw; row < T; row += nw) {
    float* xr = p.out + (size_t)row * DM;
    float4 v[8];
    float ss = 0.f;
#pragma unroll
    for (int i = 0; i < 8; ++i) {
      v[i] = *(const float4*)(xr + i * 256 + lane * 4);
      ss += v[i].x * v[i].x + v[i].y * v[i].y + v[i].z * v[i].z + v[i].w * v[i].w;
    }
#pragma unroll
    for (int o = 32; o >= 1; o >>= 1) ss += __shfl_xor(ss, o);
    float rsv = rsqrtf(ss * (1.f / DM) + EPS);
#pragma unroll
    for (int i = 0; i < 8; ++i) {
      float4 g = *(const float4*)(p.final_g + i * 256 + lane * 4);
      float4 o4;
      o4.x = v[i].x * rsv * g.x; o4.y = v[i].y * rsv * g.y; o4.z = v[i].z * rsv * g.z; o4.w = v[i].w * rsv * g.w;
      *(float4*)(xr + i * 256 + lane * 4) = o4;
    }
  }
}

#define LAS __attribute__((address_space(3)))
constexpr int BM = 256, BK = 64, HALF = 128, HTB = HALF * BK * 2, GK = 2048;
typedef f32x4 acc_t[2][2][4][2];
__device__ __forceinline__ int lds_byte(int r, int c) {
  const int st = (r >> 4) * 2 + (c >> 5), rr = r & 15, cc = c & 31, ob = rr * 64 + cc * 2;
  return st * 1024 + (ob ^ (((ob >> 9) & 1) << 5));
}
__device__ __forceinline__ void stage_rc(int b, int& R, int& C) {
  const int st = b / 1024, sb = b % 1024, swz = sb ^ (((sb >> 9) & 1) << 5);
  R = (st >> 1) * 16 + swz / 64;
  C = (st & 1) * 32 + (swz % 64) / 2;
}
__device__ __forceinline__ int perm32(int rho) { const int n = rho >> 4, i = rho & 15; return 8 * (i >> 2) + 4 * n + (i & 3); }
struct Unit { int pm, pn, aux; const char* A; const char* B; };

__device__ __forceinline__ void tile_map(int wgid, int nM, int nN, int& pm, int& pn) {
  int nwg = nM * nN;
  int q = nwg / 8, r = nwg % 8, xcd = wgid % 8, off = wgid / 8;
  wgid = (xcd < r ? xcd * (q + 1) : r * (q + 1) + (xcd - r) * q) + off;
  int nig = 8 * nN, gid = wgid / nig, fm = gid * 8, gsz = min(nM - fm, 8);
  pm = fm + ((wgid % nig) % gsz);
  pn = (wgid % nig) / gsz;
}

template <class Epi, class Sched>
__device__ __forceinline__ void gemm_stream(char* lds_, const Sched& S, const Epi& E, int wave) {
  LAS unsigned char* lds = (LAS unsigned char*)lds_;
  const int lane = fresh_lane(), tid = wave * 64 + lane, wid = wave, wr = wid >> 2, wc = wid & 3, fr = lane & 15, fq = lane >> 4;
  constexpr int K = GK, nt = K / BK;
  unsigned voffA[2], voffB[2];
#pragma unroll
  for (int i = 0; i < 2; ++i) {
    int R, C;
    stage_rc(tid * 16 + i * 8192, R, C);
    const int Rb = Epi::PERM ? ((R & ~31) + perm32(R & 31)) : R;
    voffA[i] = (unsigned)(R * K + C) * 2u;
    voffB[i] = (unsigned)(Rb * K + C) * 2u;
  }
  constexpr size_t kstep = (size_t)(BK * 2), hstep = (size_t)HALF * K * 2;
  const unsigned ldsw = (unsigned)wid * 1024u;
  const int aoff = lds_byte(wr * 64 + fr, fq * 8), boff = lds_byte(wc * 32 + fr, fq * 8);
#define G_SA(b, h) (((b) * 2 + (h)) * HTB)
#define G_SB(b, h) ((4 + (b) * 2 + (h)) * HTB)
#define G_STAGE(bufoff, gbase, voff)                                                                               \
  do {                                                                                                             \
    _Pragma("unroll") for (int _i = 0; _i < 2; ++_i) __builtin_amdgcn_global_load_lds(                             \
        (const unsigned*)((const char*)(gbase) + (voff)[_i]), (LAS unsigned*)(lds + (bufoff) + ldsw + _i * 8192), 16, 0, 0); \
  } while (0)
#define G_LDA(dst, b, h)                                                                                           \
  do {                                                                                                             \
    _Pragma("unroll") for (int m = 0; m < 4; ++m) _Pragma("unroll") for (int k = 0; k < 2; ++k) dst[m][k] =        \
        *(const LAS bf16x8*)(lds + G_SA(b, h) + aoff + m * 2048 + k * 1024);                                       \
  } while (0)
#define G_LDB(dst, b, h)                                                                                           \
  do {                                                                                                             \
    _Pragma("unroll") for (int n = 0; n < 2; ++n) _Pragma("unroll") for (int k = 0; k < 2; ++k) dst[n][k] =        \
        *(const LAS bf16x8*)(lds + G_SB(b, h) + boff + n * 2048 + k * 1024);                                       \
  } while (0)
#define G_MMA(ai, bj, At_, Bt_)                                                                                    \
  do {                                                                                                             \
    __builtin_amdgcn_s_setprio(1);                                                                                 \
    _Pragma("unroll") for (int m = 0; m < 4; ++m) _Pragma("unroll") for (int n = 0; n < 2; ++n)                    \
        _Pragma("unroll") for (int k = 0; k < 2; ++k) acc[ai][bj][m][n] =                                          \
            __builtin_amdgcn_mfma_f32_16x16x32_bf16(Bt_[n][k], At_[m][k], acc[ai][bj][m][n], 0, 0, 0);            \
    __builtin_amdgcn_s_setprio(0);                                                                                 \
  } while (0)
#define G_WAIT_V(n) asm volatile("s_waitcnt vmcnt(" #n ")" ::: "memory")
#define G_WAIT_L(n) asm volatile("s_waitcnt lgkmcnt(" #n ")" ::: "memory")
#define G_BAR __builtin_amdgcn_s_barrier()
#define G_SCHED __builtin_amdgcn_sched_barrier(0)
#define G_ZERO_ACC()                                                                                               \
  do {                                                                                                             \
    _Pragma("unroll") for (int a = 0; a < 2; ++a) _Pragma("unroll") for (int b = 0; b < 2; ++b)                    \
        _Pragma("unroll") for (int m = 0; m < 4; ++m) _Pragma("unroll") for (int n = 0; n < 2; ++n)                \
            acc[a][b][m][n] = (f32x4){0.f, 0.f, 0.f, 0.f};                                                         \
  } while (0)
  Unit cur, nxt;
  int ui = 0;
  if (!S.next(0, cur)) return;
  acc_t acc;
  G_ZERO_ACC();
  bf16x8 At[4][2], B0[2][2], B1[2][2];
  const char* cA = cur.A;
  const char* cB = cur.B;
  G_STAGE(G_SB(0, 0), cB, voffB); G_STAGE(G_SA(0, 0), cA, voffA); G_STAGE(G_SB(0, 1), cB + hstep, voffB); G_STAGE(G_SA(0, 1), cA + hstep, voffA);
  if (wr == 1) G_BAR;
  G_WAIT_V(4); G_BAR;
  G_STAGE(G_SB(1, 0), cB + kstep, voffB); G_STAGE(G_SA(1, 0), cA + kstep, voffA); G_STAGE(G_SB(1, 1), cB + hstep + kstep, voffB);
  G_WAIT_V(6); G_BAR;
  for (;;) {
    const bool has_next = S.next(ui + 1, nxt);
    const char* nA = has_next ? nxt.A : cA;
    const char* nB = has_next ? nxt.B : cB;
    for (int t = 0; t < nt; t += 2) {
      const bool last = (t == nt - 2);
      const char* a1 = cA + (size_t)(t + 1) * kstep;
      const char* a2 = last ? nA : cA + (size_t)(t + 2) * kstep;
      const char* b2 = last ? nB : cB + (size_t)(t + 2) * kstep;
      const char* a3 = a2 + kstep;
      const char* b3 = b2 + kstep;
      G_LDB(B0, 0, 0); G_SCHED; G_LDA(At, 0, 0); G_STAGE(G_SA(1, 1), a1 + hstep, voffA);
      G_WAIT_L(8); G_BAR; G_WAIT_L(0); G_MMA(0, 0, At, B0); G_BAR; G_SCHED;
      G_LDB(B1, 0, 1); G_STAGE(G_SB(0, 0), b2, voffB);
      G_BAR; G_WAIT_L(0); G_MMA(0, 1, At, B1); G_BAR;
      G_LDA(At, 0, 1); G_STAGE(G_SA(0, 0), a2, voffA);
      G_BAR; G_WAIT_L(0); G_MMA(1, 0, At, B0); G_BAR; G_SCHED;
      G_STAGE(G_SB(0, 1), b2 + hstep, voffB);
      G_WAIT_V(6); G_BAR; G_MMA(1, 1, At, B1); G_BAR;
      G_LDB(B0, 1, 0); G_SCHED; G_LDA(At, 1, 0); G_STAGE(G_SA(0, 1), a2 + hstep, voffA);
      G_WAIT_L(8); G_BAR; G_WAIT_L(0); G_MMA(0, 0, At, B0); G_BAR; G_SCHED;
      G_LDB(B1, 1, 1); G_STAGE(G_SB(1, 0), b3, voffB);
      G_BAR; G_WAIT_L(0); G_MMA(0, 1, At, B1); G_BAR;
      G_LDA(At, 1, 1); G_STAGE(G_SA(1, 0), a3, voffA);
      G_BAR; G_WAIT_L(0); G_MMA(1, 0, At, B0); G_BAR; G_SCHED;
      G_STAGE(G_SB(1, 1), b3 + hstep, voffB);
      G_WAIT_V(6); G_BAR; G_MMA(1, 1, At, B1); G_BAR;
    }
    const bool zero = E(acc, cur, wr, wc, fr, fq);
    if (!has_next) break;
    if (zero) G_ZERO_ACC();
    cur = nxt; cA = nA; cB = nB; ++ui;
  }
  G_WAIT_V(0);
  if (wr == 0) G_BAR;
  G_BAR;
#undef G_SA
#undef G_SB
#undef G_STAGE
#undef G_LDA
#undef G_LDB
#undef G_MMA
}

struct SchedIn {
  const char* A; const char* B; int G, c;
  __device__ __forceinline__ bool next(int i, Unit& u) const {
    const int L = i * G + c;
    if (L >= 64 * 64) return false;
    tile_map(L, 64, 64, u.pm, u.pn);
    u.aux = 0;
    u.A = A + (size_t)u.pm * 256 * GK * 2;
    u.B = B + (size_t)u.pn * 256 * GK * 2;
    return true;
  }
};
struct EpiIn {
  static constexpr bool PERM = true;
  unsigned char* ws; const float* rs;
  __device__ __forceinline__ bool operator()(const acc_t& acc, const Unit& u, int wr, int wc, int fr, int fq) const {
    const int bcol = u.pn * 256;
    const int seg = bcol < 1024 ? 0 : bcol < 2048 ? 1 : bcol < 4096 ? 2 : 3 + (bcol - 4096) / 2048;
    const int cbase = seg == 0 ? 0 : seg == 1 ? 1024 : seg == 2 ? 2048 : 4096 + (seg - 3) * 2048;
    const int w = seg < 2 ? 1024 : 2048;
    const size_t off_rm = seg == 0 ? WS_Q : seg == 1 ? WS_K : seg == 3 ? WS_O : seg == 4 ? WS_ZA : seg == 5 ? WS_XBP
                        : seg == 6 ? WS_ZB : seg == 7 ? WS_GA : WS_GB;
    const int row0 = u.pm * 256 + wr * 64 + fr, col0 = bcol - cbase + wc * 32 + 8 * fq;
    u16* dst_rm = (u16*)(ws + off_rm);
    u16* dst_t = (u16*)(ws + (seg == 1 ? WS_KT : WS_VT));
#pragma unroll
    for (int ai = 0; ai < 2; ++ai)
#pragma unroll
      for (int m = 0; m < 4; ++m) {
        const int row = row0 + ai * HALF + m * 16;
        const float sc = rs[row];
#pragma unroll
        for (int bj = 0; bj < 2; ++bj) {
          f32x4 v0 = acc[ai][bj][m][0] * sc, v1 = acc[ai][bj][m][1] * sc;
          u32x4 wv;
          wv.x = cvt_pk_bf16(v0[0], v0[1]); wv.y = cvt_pk_bf16(v0[2], v0[3]);
          wv.z = cvt_pk_bf16(v1[0], v1[1]); wv.w = cvt_pk_bf16(v1[2], v1[3]);
          const int col = col0 + bj * HALF;
          if (seg != 2) *(u32x4*)(dst_rm + (size_t)row * w + col) = wv;
          if (seg == 1 || seg == 2) {
            u16* d = dst_t + ((size_t)(row >> 6) * w + col) * 64 + (row & 63);
            d[0] = (u16)(wv.x & 0xffff); d[64] = (u16)(wv.x >> 16); d[128] = (u16)(wv.y & 0xffff); d[192] = (u16)(wv.y >> 16);
            d[256] = (u16)(wv.z & 0xffff); d[320] = (u16)(wv.z >> 16); d[384] = (u16)(wv.w & 0xffff); d[448] = (u16)(wv.w >> 16);
          }
        }
        __builtin_amdgcn_sched_barrier(0);
      }
    return true;
  }
};
__device__ __forceinline__ void phase_inproj(const Params& p, int layer, char* lds, int wave) {
  SchedIn S{(const char*)(p.ws + WS_XB16), (const char*)(p.ws + (layer ? WS_WT1 : WS_WT0)), (int)gridDim.x, (int)blockIdx.x};
  EpiIn E{p.ws, (const float*)(p.ws + WS_RS)};
  gemm_stream(lds, S, E, wave);
}

struct SchedBr {
  const char *YA, *YB, *WA, *WB; int G, c;
  __device__ __forceinline__ bool next(int i, Unit& u) const {
    const int L = (i >> 1) * G + c;
    if (L >= 64 * 8) return false;
    tile_map(L, 64, 8, u.pm, u.pn);
    u.aux = i & 1;
    u.A = (u.aux ? YA : YB) + (size_t)u.pm * 256 * GK * 2;
    u.B = (u.aux ? WA : WB) + (size_t)u.pn * 256 * GK * 2;
    return true;
  }
};
struct EpiBr {
  static constexpr bool PERM = true;
  const u16 *GA, *GB; u16* MG;
  __device__ __forceinline__ bool operator()(acc_t& acc, const Unit& u, int wr, int wc, int fr, int fq) const {
    const int row0 = u.pm * 256 + wr * 64 + fr, col0 = u.pn * 256 + wc * 32 + 8 * fq;
#pragma unroll
    for (int ai = 0; ai < 2; ++ai)
#pragma unroll
      for (int m = 0; m < 4; ++m) {
#pragma unroll
        for (int bj = 0; bj < 2; ++bj) {
          const size_t idx = (size_t)(row0 + ai * HALF + m * 16) * DM + col0 + bj * HALF;
          bf16x8 ga = *(const bf16x8*)(GA + idx);
          if (u.aux == 0) {
            bf16x8 gb = *(const bf16x8*)(GB + idx);
#pragma unroll
            for (int e = 0; e < 8; ++e) {
              float ea = __expf(-bf2f((u16)ga[e])), eb = __expf(-bf2f((u16)gb[e]));
              acc[ai][bj][m][e >> 2][e & 3] *= (1.f + ea) * __builtin_amdgcn_rcpf(1.f + eb);
            }
          } else {
            float o[8];
#pragma unroll
            for (int e = 0; e < 8; ++e) o[e] = acc[ai][bj][m][e >> 2][e & 3] * __builtin_amdgcn_rcpf(1.f + __expf(-bf2f((u16)ga[e])));
            u32x4 wv;
            wv.x = cvt_pk_bf16(o[0], o[1]); wv.y = cvt_pk_bf16(o[2], o[3]); wv.z = cvt_pk_bf16(o[4], o[5]); wv.w = cvt_pk_bf16(o[6], o[7]);
            *(u32x4*)(MG + idx) = wv;
          }
        }
        __builtin_amdgcn_sched_barrier(0);
      }
    return u.aux != 0;
  }
};
__device__ __forceinline__ void phase_branch(const Params& p, int layer, char* lds, int wave) {
  const char* wsm = (const char*)(p.ws + WS_WSM + (size_t)layer * WSM_STRIDE);
  SchedBr S{(const char*)(p.ws + WS_ZA), (const char*)(p.ws + WS_ZB), wsm, wsm + 8 * MiB, (int)gridDim.x, (int)blockIdx.x};
  EpiBr E{(const u16*)(p.ws + WS_GA), (const u16*)(p.ws + WS_GB), (u16*)(p.ws + WS_O)};
  gemm_stream(lds, S, E, wave);
}

struct SchedOut {
  const char *A, *B; int G, c;
  __device__ __forceinline__ bool next(int i, Unit& u) const {
    const int L = i * G + c;
    if (L >= 64 * 8) return false;
    tile_map(L, 64, 8, u.pm, u.pn);
    u.aux = 0;
    u.A = A + (size_t)u.pm * 256 * GK * 2;
    u.B = B + (size_t)u.pn * 256 * GK * 2;
    return true;
  }
};
struct EpiOut {
  static constexpr bool PERM = false;
  const float* xres; float* out;
  __device__ __forceinline__ bool operator()(const acc_t& acc, const Unit& u, int wr, int wc, int fr, int fq) const {
    const int row0 = u.pm * 256 + wr * 64 + fr, col0 = u.pn * 256 + wc * 32 + 4 * fq;
#pragma unroll
    for (int ai = 0; ai < 2; ++ai)
#pragma unroll
      for (int m = 0; m < 4; ++m) {
        const size_t rb = (size_t)(row0 + ai * HALF + m * 16) * DM + col0;
#pragma unroll
        for (int bj = 0; bj < 2; ++bj)
#pragma unroll
          for (int n = 0; n < 2; ++n) {
            const size_t idx = rb + bj * HALF + n * 16;
            f32x4 xv = *(const f32x4*)(xres + idx);
            *(f32x4*)(out + idx) = xv + acc[ai][bj][m][n];
          }
        __builtin_amdgcn_sched_barrier(0);
      }
    return true;
  }
};
__device__ __forceinline__ void phase_outproj(const Params& p, int layer, char* lds, int wave) {
  SchedOut S{(const char*)(p.ws + WS_O), (const char*)(p.ws + WS_WSM + (size_t)layer * WSM_STRIDE + 16 * MiB), (int)gridDim.x, (int)blockIdx.x};
  EpiOut E{layer == 0 ? p.x : p.out, p.out};
  gemm_stream(lds, S, E, wave);
}

#define MFMA32(a, b, c) __builtin_amdgcn_mfma_f32_32x32x16_bf16(a, b, c, 0, 0, 0)
#define MFMA16(a, b, c) __builtin_amdgcn_mfma_f32_16x16x32_bf16(a, b, c, 0, 0, 0)

__device__ __forceinline__ void mlstm_item(const Params& p, int layer, int grp, int slice, char* lds, int wave) {
  const int b = grp >> 3, hd = (grp >> 1) & 3, dir = grp & 1;
  const int lane = fresh_lane(), tid = wave * 64 + lane, w = wave, r = lane & 31, h = lane >> 5;
  u16* Qs = (u16*)lds;
  u16* Ks = Qs + 64 * 264;
  u16* Kt = Ks + 64 * 264;
  u16* Vt = Kt + 256 * 72;
  u16* Ps = Vt + 64 * 72;
  u16* Cb = Ps + 64 * 72;
  float* vec = (float*)(Cb + 64 * 264);
  float* v_qn = vec + 656, *v_den = vec + 720, *v_n = vec + 784;
  float* Xch = (float*)Ks;
  const u16* gq = (const u16*)(p.ws + WS_Q);
  const u16* gk = (const u16*)(p.ws + WS_K);
  const u16* gkt = (const u16*)(p.ws + WS_KT);
  const u16* gvt = (const u16*)(p.ws + WS_VT);
  const float* gates = (const float*)(p.ws + WS_GATES);
  u16* hdst = (u16*)(p.ws + (dir ? WS_WT0 : WS_XB16));

  bf16x8 pq[4], pk[4], pkt[4], pv;
  float g_i = 0.f, g_f = 0.f, m_st = 0.f;
  const int gw = dir ? 2 : 1;
#define ML_ISSUE(st_)                                                                                          \
  do {                                                                                                         \
    const int chunk_ = dir ? 63 - (st_) : (st_);                                                               \
    const size_t tok_ = (size_t)b * SEQ + chunk_ * 64;                                                         \
    if (w == gw) {                                                                                             \
      const float* gp = gates + (tok_ + (dir ? 63 - lane : lane)) * 16;                                        \
      g_i = gp[dir * 4 + hd];                                                                                  \
      g_f = gp[8 + dir * 4 + hd];                                                                              \
    }                                                                                                          \
    _Pragma("unroll") for (int i = 0; i < 4; ++i) {                                                            \
      int idx = tid + 512 * i, row = idx >> 5, c16 = idx & 31;                                                 \
      pq[i] = *(const bf16x8*)(gq + (tok_ + row) * 1024 + hd * 256 + c16 * 8);                                 \
      pk[i] = *(const bf16x8*)(gk + (tok_ + row) * 1024 + hd * 256 + c16 * 8);                                 \
    }                                                                                                          \
    _Pragma("unroll") for (int i = 0; i < 4; ++i) {                                                            \
      int idx = tid + 512 * i, row = idx >> 3, c16 = idx & 7;                                                  \
      pkt[i] = *(const bf16x8*)(gkt + ((tok_ >> 6) * 1024 + hd * 256 + row) * 64 + c16 * 8);                   \
    }                                                                                                          \
    pv = *(const bf16x8*)(gvt + ((tok_ >> 6) * 2048 + hd * 512 + slice * 64 + (tid >> 3)) * 64 + (tid & 7) * 8); \
  } while (0)
#define ML_GATES(vb_)                                                                                          \
  do {                                                                                                         \
    float* vb = vec + (vb_) * 328;                                                                             \
    const int L = lane, pos = dir ? 63 - L : L;                                                                \
    float lf = fminf(g_f, 0.f) - log1pf(__expf(-fabsf(g_f)));                                                  \
    float bc = lf;                                                                                             \
    _Pragma("unroll") for (int o = 1; o < 64; o <<= 1) { float t = __shfl_up(bc, o); if (L >= o) bc += t; }    \
    float a = g_i - bc;                                                                                        \
    float cm = a;                                                                                              \
    _Pragma("unroll") for (int o = 1; o < 64; o <<= 1) { float t = __shfl_up(cm, o); if (L >= o) cm = fmaxf(cm, t); } \
    float c = fmaxf(m_st, cm);                                                                                 \
    float gtot = __shfl(bc, 63), c63 = __shfl(c, 63);                                                          \
    vb[pos] = a; vb[64 + pos] = c; vb[128 + pos] = __expf(m_st - c); vb[192 + pos] = __expf(-(c + bc));        \
    vb[256 + pos] = __expf(a - c63);                                                                           \
    if (L == 0) vb[320] = __expf(m_st - c63);                                                                  \
    m_st = gtot + c63;                                                                                         \
  } while (0)

  __syncthreads();
  ML_ISSUE(0);
  for (int i = tid; i < 64 * 264; i += 512) Cb[i] = 0;
  if (tid < 256) v_n[tid] = 0.f;
  f32x16 accC[2];
#pragma unroll
  for (int i = 0; i < 16; ++i) { accC[0][i] = 0.f; accC[1][i] = 0.f; }
  if (w == gw) ML_GATES(0);

  for (int st = 0; st < 64; ++st) {
    const int chunk = dir ? 63 - st : st;
    const size_t tok0 = (size_t)b * SEQ + chunk * 64;
    const float* v_a = vec + (st & 1) * 328, *v_c = v_a + 64, *v_wi = v_a + 128, *v_en = v_a + 192, *v_wk = v_a + 256,
               *v_sc = v_a + 320;
    __syncthreads();
#pragma unroll
    for (int i = 0; i < 4; ++i) {
      int idx = tid + 512 * i, row = idx >> 5, c16 = idx & 31;
      *(bf16x8*)(Qs + row * 264 + c16 * 8) = pq[i];
      *(bf16x8*)(Ks + row * 264 + c16 * 8) = pk[i];
    }
#pragma unroll
    for (int i = 0; i < 4; ++i) {
      int idx = tid + 512 * i, row = idx >> 3, c16 = idx & 7;
      *(bf16x8*)(Kt + row * 72 + c16 * 8) = pkt[i];
    }
    *(bf16x8*)(Vt + (tid >> 3) * 72 + (tid & 7) * 8) = pv;
    if (st + 1 < 64) ML_ISSUE(st + 1);
    __syncthreads();
    if (w < 4) {
      int jb = w >> 1, sb = w & 1;
      bool skip = dir ? (sb < jb) : (sb > jb);
      f32x16 sacc;
#pragma unroll
      for (int i = 0; i < 16; ++i) sacc[i] = 0.f;
      if (!skip) {
#pragma unroll 4
        for (int kk = 0; kk < 16; ++kk) {
          bf16x8 af = *(const bf16x8*)(Qs + (jb * 32 + r) * 264 + kk * 16 + h * 8);
          bf16x8 bfr = *(const bf16x8*)(Ks + (sb * 32 + r) * 264 + kk * 16 + h * 8);
          sacc = MFMA32(af, bfr, sacc);
        }
      }
      int s = sb * 32 + r;
      float as_ = v_a[s];
#pragma unroll
      for (int reg = 0; reg < 16; ++reg) {
        int j = jb * 32 + (reg & 3) + 8 * (reg >> 2) + 4 * h;
        bool valid = dir ? (s >= j) : (s <= j);
        float pv_ = (valid && !skip) ? sacc[reg] * __expf(as_ - v_c[j]) : 0.f;
        Ps[j * 72 + s] = f2bf(pv_);
      }
      if (w == gw && st + 1 < 64) ML_GATES((st + 1) & 1);
    } else {
      int t2 = tid - 256, j = t2 >> 2, part = t2 & 3;
      float sum = 0.f;
#pragma unroll
      for (int k8 = 0; k8 < 8; ++k8) {
        bf16x8 qv = *(const bf16x8*)(Qs + j * 264 + part * 64 + k8 * 8);
        float4 n0 = *(const float4*)(v_n + part * 64 + k8 * 8), n1 = *(const float4*)(v_n + part * 64 + k8 * 8 + 4);
        sum += bf2f((u16)qv[0]) * n0.x + bf2f((u16)qv[1]) * n0.y + bf2f((u16)qv[2]) * n0.z + bf2f((u16)qv[3]) * n0.w +
               bf2f((u16)qv[4]) * n1.x + bf2f((u16)qv[5]) * n1.y + bf2f((u16)qv[6]) * n1.z + bf2f((u16)qv[7]) * n1.w;
      }
      sum += __shfl_xor(sum, 1);
      sum += __shfl_xor(sum, 2);
      if (part == 0) v_qn[j] = sum;
    }
    __syncthreads();
    {
      int t = w & 3, jb = t >> 1, vb = t & 1, kh = w >> 2;
      f32x16 acc;
#pragma unroll
      for (int i = 0; i < 16; ++i) acc[i] = 0.f;
#pragma unroll 4
      for (int kk = kh * 8; kk < kh * 8 + 8; ++kk) {
        bf16x8 af = *(const bf16x8*)(Qs + (jb * 32 + r) * 264 + kk * 16 + h * 8);
        bf16x8 bfr = *(const bf16x8*)(Cb + (vb * 32 + r) * 264 + kk * 16 + h * 8);
        acc = MFMA32(af, bfr, acc);
      }
#pragma unroll
      for (int reg = 0; reg < 16; ++reg) acc[reg] *= v_wi[jb * 32 + (reg & 3) + 8 * (reg >> 2) + 4 * h];
#pragma unroll
      for (int ss = kh * 2; ss < kh * 2 + 2; ++ss) {
        bf16x8 af = *(const bf16x8*)(Ps + (jb * 32 + r) * 72 + ss * 16 + h * 8);
        bf16x8 bfr = *(const bf16x8*)(Vt + (vb * 32 + r) * 72 + ss * 16 + h * 8);
        acc = MFMA32(af, bfr, acc);
      }
      if (kh == 1) {
#pragma unroll
        for (int reg = 0; reg < 16; ++reg) Xch[t * 1024 + reg * 64 + lane] = acc[reg];
        int t2 = tid - 256, j = t2 >> 2, part = t2 & 3;
        float sum = 0.f;
#pragma unroll
        for (int k8 = 0; k8 < 2; ++k8) {
          bf16x8 pv_ = *(const bf16x8*)(Ps + j * 72 + part * 16 + k8 * 8);
#pragma unroll
          for (int e = 0; e < 8; ++e) sum += bf2f((u16)pv_[e]);
        }
        sum += __shfl_xor(sum, 1);
        sum += __shfl_xor(sum, 2);
        if (part == 0) v_den[j] = sum + v_wi[j] * v_qn[j];
      }
      __syncthreads();
      if (kh == 0) {
#pragma unroll
        for (int reg = 0; reg < 16; ++reg) {
          int j = jb * 32 + (reg & 3) + 8 * (reg >> 2) + 4 * h;
          float num = acc[reg] + Xch[t * 1024 + reg * 64 + lane];
          float dn = fmaxf(fabsf(v_den[j]), v_en[j]);
          hdst[(tok0 + j) * DM + hd * 512 + slice * 64 + vb * 32 + r] = f2bf(num * __builtin_amdgcn_rcpf(dn));
        }
      }
    }
    {
      int row = tid >> 3, c16 = tid & 7;
      bf16x8 vv = *(const bf16x8*)(Vt + row * 72 + c16 * 8);
      float4 w0 = *(const float4*)(v_wk + c16 * 8), w1 = *(const float4*)(v_wk + c16 * 8 + 4);
      vv[0] = (short)f2bf(bf2f((u16)vv[0]) * w0.x); vv[1] = (short)f2bf(bf2f((u16)vv[1]) * w0.y);
      vv[2] = (short)f2bf(bf2f((u16)vv[2]) * w0.z); vv[3] = (short)f2bf(bf2f((u16)vv[3]) * w0.w);
      vv[4] = (short)f2bf(bf2f((u16)vv[4]) * w1.x); vv[5] = (short)f2bf(bf2f((u16)vv[5]) * w1.y);
      vv[6] = (short)f2bf(bf2f((u16)vv[6]) * w1.z); vv[7] = (short)f2bf(bf2f((u16)vv[7]) * w1.w);
      *(bf16x8*)(Vt + row * 72 + c16 * 8) = vv;
      if (tid >= 256) {
        int k = tid - 256;
        float sum = v_sc[0] * v_n[k];
#pragma unroll
        for (int k8 = 0; k8 < 8; ++k8) {
          bf16x8 kv = *(const bf16x8*)(Kt + k * 72 + k8 * 8);
          float4 x0 = *(const float4*)(v_wk + k8 * 8), x1 = *(const float4*)(v_wk + k8 * 8 + 4);
          sum += bf2f((u16)kv[0]) * x0.x + bf2f((u16)kv[1]) * x0.y + bf2f((u16)kv[2]) * x0.z + bf2f((u16)kv[3]) * x0.w +
                 bf2f((u16)kv[4]) * x1.x + bf2f((u16)kv[5]) * x1.y + bf2f((u16)kv[6]) * x1.z + bf2f((u16)kv[7]) * x1.w;
        }
        v_n[k] = sum;
      }
    }
    __syncthreads();
    {
      float decay = v_sc[0];
#pragma unroll
      for (int i = 0; i < 16; ++i) { accC[0][i] *= decay; accC[1][i] *= decay; }
#pragma unroll
      for (int ss = 0; ss < 4; ++ss) {
        bf16x8 af = *(const bf16x8*)(Kt + (32 * w + r) * 72 + ss * 16 + h * 8);
        bf16x8 b0 = *(const bf16x8*)(Vt + (r) * 72 + ss * 16 + h * 8);
        bf16x8 b1 = *(const bf16x8*)(Vt + (32 + r) * 72 + ss * 16 + h * 8);
        accC[0] = MFMA32(af, b0, accC[0]);
        accC[1] = MFMA32(af, b1, accC[1]);
      }
#pragma unroll
      for (int vb = 0; vb < 2; ++vb)
#pragma unroll
        for (int g = 0; g < 4; ++g) {
          u16x4 pk4 = {f2bf(accC[vb][4 * g]), f2bf(accC[vb][4 * g + 1]), f2bf(accC[vb][4 * g + 2]), f2bf(accC[vb][4 * g + 3])};
          *(u16x4*)(Cb + (vb * 32 + r) * 264 + 32 * w + 8 * g + 4 * h) = pk4;
        }
    }
  }
  __syncthreads();
#undef ML_ISSUE
#undef ML_GATES
}

template <int dir>
__device__ __forceinline__ void lru_item(const Params& p, int layer, int item, char* lds, int wave) {
  const int b = item >> 6, blk = (item >> 2) & 15, half = item & 1;
  const int lane = fresh_lane(), tid = wave * 64 + lane, w = wave, c = lane & 15, q = lane >> 4;
  const u16* xbp = (const u16*)(p.ws + WS_XBP);
  u16* hdst = (u16*)(p.ws + (dir ? WS_LHB : WS_LHF));
  __syncthreads();
  if (w >= 4) {
    const int t2 = tid - 256, cg = t2 & 15, tq = t2 >> 4;
    float cw[4][8], cbias[8];
#pragma unroll
    for (int e = 0; e < 8; ++e) {
      int ch = blk * 128 + cg * 8 + e;
      cbias[e] = p.conv_b[layer * DM + ch];
#pragma unroll
      for (int tap = 0; tap < 4; ++tap) cw[tap][e] = p.conv_w[(layer * 4 + tap) * DM + ch];
    }
    bf16x8 px[7];
#define LRU_LOAD(ti_)                                                                                      \
  do {                                                                                                     \
    const int s0_ = (dir ? 63 - (ti_) : (ti_)) * 64 + 4 * tq - 2;                                          \
    _Pragma("unroll") for (int rr = 0; rr < 7; ++rr) {                                                     \
      int sp_ = s0_ + rr;                                                                                  \
      bf16x8 z = {0, 0, 0, 0, 0, 0, 0, 0};                                                                 \
      px[rr] = (sp_ >= 0 && sp_ < SEQ) ? *(const bf16x8*)(xbp + ((size_t)b * SEQ + sp_) * DM + blk * 128 + cg * 8) : z; \
    }                                                                                                      \
  } while (0)
#define LRU_CONV(buf_)                                                                                     \
  do {                                                                                                     \
    u16* xcb = (u16*)(lds + (buf_) * 17408);                                                               \
    float* xcf = (float*)(lds + 34816 + (buf_) * 17408);                                                   \
    _Pragma("unroll") for (int tk = 0; tk < 4; ++tk) {                                                     \
      float xc[8];                                                                                         \
      _Pragma("unroll") for (int e = 0; e < 8; ++e) {                                                      \
        xc[e] = cbias[e] + cw[0][e] * bf2f((u16)px[tk][e]) + cw[1][e] * bf2f((u16)px[tk + 1][e]) +         \
                cw[2][e] * bf2f((u16)px[tk + 2][e]) + cw[3][e] * bf2f((u16)px[tk + 3][e]);                 \
      }                                                                                                    \
      bf16x8 o8;                                                                                           \
      _Pragma("unroll") for (int e = 0; e < 8; ++e) o8[e] = (short)f2bf(xc[e]);                            \
      const int tt = 4 * tq + tk;                                                                          \
      *(bf16x8*)(xcb + tt * 136 + cg * 8) = o8;                                                            \
      if ((cg >> 3) == half) {                                                                             \
        float* d = xcf + tt * 68 + (cg & 7) * 8;                                                           \
        *(float4*)d = make_float4(xc[0], xc[1], xc[2], xc[3]);                                             \
        *(float4*)(d + 4) = make_float4(xc[4], xc[5], xc[6], xc[7]);                                       \
      }                                                                                                    \
    }                                                                                                      \
  } while (0)
    LRU_LOAD(0);
    LRU_CONV(0);
    LRU_LOAD(1);
    __syncthreads();
    for (int ti = 0; ti < 64; ++ti) {
      if (ti + 1 < 64) {
        LRU_CONV((ti + 1) & 1);
        if (ti + 2 < 64) LRU_LOAD(ti + 2);
      }
      __syncthreads();
    }
#undef LRU_LOAD
#undef LRU_CONV
  } else {
    bf16x8 Br[4], Bi[4];
    const int chl = half * 64 + 16 * w + c, ch = blk * 128 + chl;
    const u16* wrg = (const u16*)(p.ws + WS_WSM + (size_t)layer * WSM_STRIDE + 24 * MiB);
    const u16* wr_ = wrg + ((size_t)((dir * 2 + 0) * 16 + blk)) * 16384 + chl * 128;
    const u16* wi_ = wrg + ((size_t)((dir * 2 + 1) * 16 + blk)) * 16384 + chl * 128;
#pragma unroll
    for (int kk = 0; kk < 4; ++kk) {
      Br[kk] = *(const bf16x8*)(wr_ + kk * 32 + q * 8);
      Bi[kk] = *(const bf16x8*)(wi_ + kk * 32 + q * 8);
    }
    const float br = p.b_rg[((layer * 2 + dir) * 2 + 0) * DM + ch];
    const float bi = p.b_rg[((layer * 2 + dir) * 2 + 1) * DM + ch];
    const float lam = p.lam[(layer * 2 + dir) * DM + ch];
    const float sp8 = -8.f * (fmaxf(-lam, 0.f) + log1pf(__expf(-fabsf(lam))));
    float carry = 0.f;
    __syncthreads();
    for (int ti = 0; ti < 64; ++ti) {
      const int tile = dir ? 63 - ti : ti, s0 = tile * 64;
      const u16* xcb = (const u16*)(lds + (ti & 1) * 17408);
      const float* xcf = (const float*)(lds + 34816 + (ti & 1) * 17408);
      f32x4 ar[4], ai_[4];
#pragma unroll
      for (int m = 0; m < 4; ++m) {
        ar[m] = f32x4{0.f, 0.f, 0.f, 0.f};
        ai_[m] = f32x4{0.f, 0.f, 0.f, 0.f};
#pragma unroll
        for (int kk = 0; kk < 4; ++kk) {
          bf16x8 af = *(const bf16x8*)(xcb + (16 * m + c) * 136 + kk * 32 + q * 8);
          ar[m] = MFMA16(af, Br[kk], ar[m]);
          ai_[m] = MFMA16(af, Bi[kk], ai_[m]);
        }
      }
#pragma unroll
      for (int mi = 0; mi < 4; ++mi) {
        const int m = dir ? 3 - mi : mi;
        float a_[4], u_[4];
#pragma unroll
        for (int i = 0; i < 4; ++i) {
          float rg = sigmoidf_(ar[m][i] + br), ig = sigmoidf_(ai_[m][i] + bi);
          float a = __expf(sp8 * rg);
          float xv = xcf[(16 * m + 4 * q + i) * 68 + 16 * w + c];
          a_[i] = a;
          u_[i] = sqrtf(fmaxf(1.f - a * a, 0.f)) * ig * xv;
        }
        float A4 = a_[0] * a_[1] * a_[2] * a_[3];
        float hv[4];
        if (!dir) {
          float U4 = ((u_[0] * a_[1] + u_[1]) * a_[2] + u_[2]) * a_[3] + u_[3];
          float hin = carry;
#pragma unroll
          for (int qq = 0; qq < 3; ++qq) {
            float Aq = __shfl(A4, qq * 16 + c), Uq = __shfl(U4, qq * 16 + c);
            if (qq < q) hin = Aq * hin + Uq;
          }
          hv[0] = a_[0] * hin + u_[0];
          hv[1] = a_[1] * hv[0] + u_[1];
          hv[2] = a_[2] * hv[1] + u_[2];
          hv[3] = a_[3] * hv[2] + u_[3];
          carry = __shfl(hv[3], 48 + c);
        } else {
          float U4 = ((u_[3] * a_[2] + u_[2]) * a_[1] + u_[1]) * a_[0] + u_[0];
          float hin = carry;
#pragma unroll
          for (int qq = 3; qq > 0; --qq) {
            float Aq = __shfl(A4, qq * 16 + c), Uq = __shfl(U4, qq * 16 + c);
            if (qq > q) hin = Aq * hin + Uq;
          }
          hv[3] = a_[3] * hin + u_[3];
          hv[2] = a_[2] * hv[3] + u_[2];
          hv[1] = a_[1] * hv[2] + u_[1];
          hv[0] = a_[0] * hv[1] + u_[0];
          carry = __shfl(hv[0], c);
        }
#pragma unroll
        for (int i = 0; i < 4; ++i)
          hdst[((size_t)b * SEQ + s0 + 16 * m + 4 * q + i) * DM + ch] = f2bf(hv[i]);
      }
      __syncthreads();
    }
  }
  __syncthreads();
}

__device__ __forceinline__ void phase_mixers(const Params& p, int layer, char* lds, int wave) {
  for (int it = blockIdx.x; it < 512; it += gridDim.x) {
    if (it < 256) {
      int j = it >> 3;
      mlstm_item(p, layer, (it & 7) * 4 + (j >> 3), j & 7, lds, wave);
    } else {
      if (((it - 256) >> 1) & 1) lru_item<1>(p, layer, it - 256, lds, wave);
      else lru_item<0>(p, layer, it - 256, lds, wave);
    }
  }
}

template <bool PROBE = false>
__device__ __forceinline__ void phase_post(const Params& p, int layer, int wave) {
  int lane = fresh_lane(), wid = wave;
  int gw = blockIdx.x * 8 + wid, nw = gridDim.x * 8;
  const u16* hf = (const u16*)(p.ws + WS_XB16);
  const u16* hb = (const u16*)(p.ws + WS_WT0);
  const u16* lf = (const u16*)(p.ws + WS_LHF);
  const u16* lb = (const u16*)(p.ws + WS_LHB);
  const u16* o = (const u16*)(p.ws + WS_O);
  u16* za = (u16*)(p.ws + WS_ZA);
  u16* zb = (u16*)(p.ws + WS_ZB);
  for (int wi0 = gw; wi0 < T * 4; wi0 += 2 * nw) {
    bf16x8 f8[2], b8[2], o8[2], z8[2], lf8[2], lb8[2], zb8[2];
    size_t off[2];
#pragma unroll
    for (int u = 0; u < 2; ++u) {
      int wi = wi0 + u * nw;
      off[u] = (size_t)(wi >> 2) * DM + (wi & 3) * 512 + lane * 8;
      f8[u] = *(const bf16x8*)(hf + off[u]); b8[u] = *(const bf16x8*)(hb + off[u]);
      o8[u] = *(const bf16x8*)(o + off[u]); z8[u] = *(const bf16x8*)(za + off[u]);
      lf8[u] = *(const bf16x8*)(lf + off[u]); lb8[u] = *(const bf16x8*)(lb + off[u]); zb8[u] = *(const bf16x8*)(zb + off[u]);
    }
#pragma unroll
    for (int u = 0; u < 2; ++u) {
      int wi = wi0 + u * nw;
      int col = (wi & 3) * 512 + lane * 8;
      float hv[8], ss = 0.f;
#pragma unroll
      for (int e = 0; e < 8; ++e) { hv[e] = bf2f((u16)f8[u][e]) + bf2f((u16)b8[u][e]); ss += hv[e] * hv[e]; }
#pragma unroll
      for (int s = 32; s >= 1; s >>= 1) ss += __shfl_xor(ss, s);
      float rn = rsqrtf(ss * (1.f / 512.f) + EPS);
      const float4 hg0 = *(const float4*)(p.head_g + layer * DM + col), hg1 = *(const float4*)(p.head_g + layer * DM + col + 4);
      const float hg[8] = {hg0.x, hg0.y, hg0.z, hg0.w, hg1.x, hg1.y, hg1.z, hg1.w};
      float ya[8], yb[8];
#pragma unroll
      for (int e = 0; e < 8; ++e) {
        float ov = bf2f((u16)o8[u][e]), zv = bf2f((u16)z8[u][e]);
        ya[e] = hv[e] * rn * hg[e] * zv * __builtin_amdgcn_rcpf((1.f + __expf(-ov)) * (1.f + __expf(-zv)));
        float zbv = bf2f((u16)zb8[u][e]);
        yb[e] = (bf2f((u16)lf8[u][e]) + bf2f((u16)lb8[u][e])) * zbv * __builtin_amdgcn_rcpf(1.f + __expf(-zbv));
      }
      u32x4 wa, wb;
      wa.x = cvt_pk_bf16(ya[0], ya[1]); wa.y = cvt_pk_bf16(ya[2], ya[3]); wa.z = cvt_pk_bf16(ya[4], ya[5]); wa.w = cvt_pk_bf16(ya[6], ya[7]);
      wb.x = cvt_pk_bf16(yb[0], yb[1]); wb.y = cvt_pk_bf16(yb[2], yb[3]); wb.z = cvt_pk_bf16(yb[4], yb[5]); wb.w = cvt_pk_bf16(yb[6], yb[7]);
      *(u32x4*)((PROBE ? (u16*)(p.ws + WS_Q) : za) + off[u]) = wa;
      *(u32x4*)((PROBE ? (u16*)(p.ws + WS_Q + 64 * MiB) : zb) + off[u]) = wb;
    }
  }
}

constexpr int NPHASE = 13;
#define PH(n, code)                         \
  if (ph_lo <= (n) && (n) < ph_hi) {        \
    if ((n) > ph_lo) cg::this_grid().sync(); \
    code;                                   \
  }
__global__ void __launch_bounds__(512, 2) mega(Params p, int ph_lo, int ph_hi) {
  extern __shared__ __attribute__((aligned(16))) char lds[];
  const int wave = __builtin_amdgcn_readfirstlane(threadIdx.x >> 6);
  PH(0, { phase_convert(p, lds, wave); if (PROBE_DUP == 5) phase_convert(p, lds, wave); phase_rowpass(p, 0, p.x, wave); })
  PH(1, { phase_inproj(p, 0, lds, wave); if (PROBE_DUP == 1) { __syncthreads(); phase_inproj(p, 0, lds, wave); } })
  PH(2, { phase_mixers(p, 0, lds, wave);
          if (PROBE_DUP == 2) { int j = blockIdx.x >> 3; mlstm_item(p, 0, (blockIdx.x & 7) * 4 + (j >> 3), j & 7, lds, wave); }
          if (PROBE_DUP == 3) { if ((blockIdx.x >> 1) & 1) lru_item<1>(p, 0, blockIdx.x, lds, wave); else lru_item<0>(p, 0, blockIdx.x, lds, wave); } })
  PH(3, { if (PROBE_DUP == 8) phase_post<true>(p, 0, wave); phase_post(p, 0, wave); })
  PH(4, { phase_branch(p, 0, lds, wave); if (PROBE_DUP == 4) { __syncthreads(); phase_branch(p, 0, lds, wave); } })
  PH(5, phase_outproj(p, 0, lds, wave))
  PH(6, { phase_rowpass(p, 1, p.out, wave);
          if (PROBE_DUP == 6) phase_rowpass(p, 1, p.out, wave);
          if (PROBE_DUP == 7) { for (int i = 0; i < 10; ++i) cg::this_grid().sync(); } })
  PH(7, phase_inproj(p, 1, lds, wave))
  PH(8, phase_mixers(p, 1, lds, wave))
  PH(9, phase_post(p, 1, wave))
  PH(10, phase_branch(p, 1, lds, wave))
  PH(11, phase_outproj(p, 1, lds, wave))
  PH(12, phase_final(p, wave))
}

extern "C" void kernel_launch(void* const* d_in, const int* in_sizes, int n_in, void* d_out, int out_size, void* d_ws,
                              size_t ws_size, hipStream_t stream) {
  static int grid = 0;
  if (grid == 0) {
    if (ws_size < WS_END) { fprintf(stderr, "workspace too small: %zu < %zu\n", ws_size, (size_t)WS_END); grid = -1; return; }
    int dev = 0, cus = 0, per_cu = 0;
    hipGetDevice(&dev);
    hipDeviceGetAttribute(&cus, hipDeviceAttributeMultiprocessorCount, dev);
    if (hipFuncSetAttribute((const void*)mega, hipFuncAttributeMaxDynamicSharedMemorySize, LDS_BYTES) != hipSuccess) {
      fprintf(stderr, "hipFuncSetAttribute failed\n"); grid = -1; return;
    }
    hipOccupancyMaxActiveBlocksPerMultiprocessor(&per_cu, (const void*)mega, 512, LDS_BYTES);
    if (per_cu < 1) { fprintf(stderr, "occupancy query says %d\n", per_cu); per_cu = 1; }
    (void)hipGetLastError();
    grid = cus * 1;
  }
  if (grid < 0) return;
  Params p{};
  p.x = (const float*)d_in[0]; p.norm_g = (const float*)d_in[1]; p.w_in = (const float*)d_in[2];
  p.b_if = (const float*)d_in[3]; p.head_g = (const float*)d_in[4]; p.conv_w = (const float*)d_in[5];
  p.conv_b = (const float*)d_in[6]; p.w_rg = (const float*)d_in[7]; p.b_rg = (const float*)d_in[8];
  p.lam = (const float*)d_in[9]; p.w_a = (const float*)d_in[10]; p.w_b = (const float*)d_in[11];
  p.w_o = (const float*)d_in[12]; p.final_g = (const float*)d_in[13];
  p.out = (float*)d_out; p.ws = (unsigned char*)d_ws;
#if COOP
  int lo = 0, hi = NPHASE;
  void* args[] = {&p, &lo, &hi};
  hipError_t e = hipLaunchCooperativeKernel((const void*)mega, dim3(grid), dim3(512), args, LDS_BYTES, stream);
  if (e != hipSuccess) fprintf(stderr, "cooperative launch failed: %s (grid %d)\n", hipGetErrorString(e), grid);
#else
  for (int ph = 0; ph < NPHASE; ++ph) hipLaunchKernelGGL(mega, dim3(grid), dim3(512), LDS_BYTES, stream, p, ph, ph + 1);
#endif
}
```

```cpp
#include <hip/hip_runtime.h>
#include <hip/hip_cooperative_groups.h>
#include <cstdio>
#include <cstdint>
namespace cg = cooperative_groups;

#ifndef PROBE_DUP
#define PROBE_DUP 0
#endif
#ifndef COOP
#define COOP 1
#endif

typedef unsigned short u16;
using bf16x8 = __attribute__((ext_vector_type(8))) short;
using u16x4 = __attribute__((ext_vector_type(4))) unsigned short;
using f32x4 = __attribute__((ext_vector_type(4))) float;
using f32x16 = __attribute__((ext_vector_type(16))) float;

constexpr int T = 16384, SEQ = 4096, DM = 2048, NIN = 16400;
constexpr float EPS = 1e-6f;
constexpr size_t MiB = 1ull << 20;
constexpr size_t WS_WT0 = 0;
constexpr size_t WS_WT1 = 64 * MiB;
constexpr size_t WS_WSM = 128 * MiB;
constexpr size_t WSM_STRIDE = 27 * MiB;
constexpr size_t WS_Q = 182 * MiB, WS_K = 214 * MiB, WS_KT = 246 * MiB, WS_VT = 278 * MiB, WS_O = 342 * MiB,
                 WS_ZA = 406 * MiB, WS_XBP = 470 * MiB, WS_ZB = 534 * MiB, WS_GA = 598 * MiB, WS_GB = 662 * MiB,
                 WS_XB16 = 726 * MiB,
                 WS_LHF = 790 * MiB, WS_LHB = 854 * MiB, WS_RS = 918 * MiB, WS_GATES = 918 * MiB + 65536,
                 WS_BAR = 920 * MiB, WS_END = 920 * MiB + 65536;
constexpr int LDS_BYTES = 160 * 1024;

struct Params {
  const float *x, *norm_g, *w_in, *b_if, *head_g, *conv_w, *conv_b, *w_rg, *b_rg, *lam, *w_a, *w_b, *w_o, *final_g;
  float* out;
  unsigned char* ws;
};

__device__ __forceinline__ u16 f2bf(float f) {
  uint32_t u = __float_as_uint(f);
  u += 0x7fffu + ((u >> 16) & 1u);
  return (u16)(u >> 16);
}
typedef unsigned u32x4 __attribute__((ext_vector_type(4)));
typedef __bf16 bf16x2_t __attribute__((ext_vector_type(2)));
typedef float f32x2_t __attribute__((ext_vector_type(2)));
__device__ __forceinline__ unsigned cvt_pk_bf16(float lo, float hi) {
  f32x2_t f = {lo, hi};
  bf16x2_t v = __builtin_convertvector(f, bf16x2_t);
  return __builtin_bit_cast(unsigned, v);
}
__device__ __forceinline__ float bf2f(u16 h) { return __uint_as_float(((uint32_t)h) << 16); }
__device__ __forceinline__ int fresh_lane() {
  int l;
  asm volatile("v_mbcnt_lo_u32_b32 %0, -1, 0\n\tv_mbcnt_hi_u32_b32 %0, -1, %0" : "=v"(l));
  return l & 63;
}
#define TID_DECL const int tid = wave * 64 + fresh_lane()
__device__ __forceinline__ float sigmoidf_(float x) { return __builtin_amdgcn_rcpf(1.f + __expf(-x)); }

__device__ __forceinline__ void tconv_tile(const float* __restrict__ src, long ld_src, int k0, int n0s, u16* __restrict__ dst,
                           long ld_dst, int n0d, const float* __restrict__ rowscale, float cs, float* tile, int wave) {
  TID_DECL;
  {
    const int c4 = tid & 31, r = tid >> 5;
#pragma unroll
    for (int i = 0; i < 8; ++i) {
      int kl = r + 16 * i;
      float4 v = *(const float4*)(src + (long)(k0 + kl) * ld_src + n0s + c4 * 4);
      float sc = cs * (rowscale ? rowscale[k0 + kl] : 1.f);
      float* t = tile + kl * 129 + c4 * 4;
      t[0] = v.x * sc; t[1] = v.y * sc; t[2] = v.z * sc; t[3] = v.w * sc;
    }
  }
  __syncthreads();
#pragma unroll
  for (int i = 0; i < 4; ++i) {
    const int id = tid + 512 * i, nl = id >> 4, kc = id & 15;
    const float* t = tile + (kc * 8) * 129 + nl;
    u32x4 wv;
    wv.x = cvt_pk_bf16(t[0], t[129]);
    wv.y = cvt_pk_bf16(t[2 * 129], t[3 * 129]);
    wv.z = cvt_pk_bf16(t[4 * 129], t[5 * 129]);
    wv.w = cvt_pk_bf16(t[6 * 129], t[7 * 129]);
    *(u32x4*)(dst + (long)(n0d + nl) * ld_dst + k0 + kc * 8) = wv;
  }
  __syncthreads();
}

__device__ __forceinline__ void phase_convert(const Params& p, char* lds, int wave) {
  TID_DECL;
  float* tile = (float*)lds;
  constexpr int PER_LAYER = 2048 + 768 + 64 + 1;
  for (int it = blockIdx.x; it < 2 * PER_LAYER; it += gridDim.x) {
    int l = it / PER_LAYER, r = it % PER_LAYER;
    unsigned char* wsm = p.ws + WS_WSM + (size_t)l * WSM_STRIDE;
    if (r < 2048) {
      int kt = r & 15, nt = r >> 4;
      int n0d = nt * 128, n0s = n0d < 8192 ? n0d : n0d + 16;
      float cs = (n0d >= 1024 && n0d < 2048) ? 0.0625f : 1.f;
      u16* dst = (u16*)(p.ws + (l ? WS_WT1 : WS_WT0));
      tconv_tile(p.w_in + (size_t)l * DM * NIN, NIN, kt * 128, n0s, dst, DM, n0d, p.norm_g + l * DM, cs, tile, wave);
    } else if (r < 2048 + 768) {
      int q = r - 2048, which = q >> 8, tt = q & 255, kt = tt & 15, nt = tt >> 4;
      const float* src = (which == 0 ? p.w_a : which == 1 ? p.w_b : p.w_o) + (size_t)l * DM * DM;
      u16* dst = (u16*)(wsm + (size_t)which * 8 * MiB);
      tconv_tile(src, DM, kt * 128, nt * 128, dst, DM, nt * 128, nullptr, 1.f, tile, wave);
    } else if (r < 2048 + 768 + 64) {
      int mat = r - 2048 - 768;
      const float* src = p.w_rg + ((size_t)l * 64 + mat) * 16384;
      u16* dst = (u16*)(wsm + 24 * MiB) + (size_t)mat * 16384;
      tconv_tile(src, 128, 0, 0, dst, 128, 0, nullptr, 1.f, tile, wave);
    } else {
      u16* dst = (u16*)(wsm + 26 * MiB);
      const float* src = p.w_in + (size_t)l * DM * NIN;
      for (int i = tid; i < 16 * DM; i += 512) {
        int j = i >> 11, k = i & 2047;
        dst[i] = f2bf(src[(size_t)k * NIN + 8192 + j] * p.norm_g[l * DM + k]);
      }
    }
  }
}

template <bool LDSWG>
__device__ __forceinline__ void phase_rowpass(const Params& p, int layer, const float* __restrict__ xin, char* lds, int wave) {
  int lane = fresh_lane(), wid = wave;
  u16* wgl = (u16*)lds;
  if (LDSWG) {
    const float* src = p.w_in + (size_t)layer * DM * NIN + 8192;
    __syncthreads();
    for (int idx = wave * 64 + lane; idx < 16 * DM; idx += 512) {
      int k = idx >> 4, j = idx & 15;
      wgl[j * 2056 + k] = f2bf(src[(size_t)k * NIN + j] * p.norm_g[layer * DM + k]);
    }
    __syncthreads();
  }
  int gw = blockIdx.x * 8 + wid, nw = gridDim.x * 8;
  int r = lane & 15, q = lane >> 4;
  u16* xb16 = (u16*)(p.ws + WS_XB16);
  float* rs = (float*)(p.ws + WS_RS);
  float* gates = (float*)(p.ws + WS_GATES);
  const u16* wg = (const u16*)(p.ws + WS_WSM + (size_t)layer * WSM_STRIDE + 26 * MiB);
  for (int rt = gw; rt < T / 16; rt += nw) {
    int row = rt * 16 + r;
    const float* xr = xin + (size_t)row * DM + q * 8;
    f32x4 acc = {0.f, 0.f, 0.f, 0.f};
    float ss = 0.f;
#pragma unroll 4
    for (int kk = 0; kk < 64; ++kk) {
      float4 a0 = *(const float4*)(xr + kk * 32);
      float4 a1 = *(const float4*)(xr + kk * 32 + 4);
      ss += a0.x * a0.x + a0.y * a0.y + a0.z * a0.z + a0.w * a0.w + a1.x * a1.x + a1.y * a1.y + a1.z * a1.z + a1.w * a1.w;
      bf16x8 af;
      af[0] = (short)f2bf(a0.x); af[1] = (short)f2bf(a0.y); af[2] = (short)f2bf(a0.z); af[3] = (short)f2bf(a0.w);
      af[4] = (short)f2bf(a1.x); af[5] = (short)f2bf(a1.y); af[6] = (short)f2bf(a1.z); af[7] = (short)f2bf(a1.w);
      *(bf16x8*)(xb16 + (size_t)row * DM + kk * 32 + q * 8) = af;
      bf16x8 bfr = LDSWG ? *(const bf16x8*)(wgl + r * 2056 + kk * 32 + q * 8)
                         : *(const bf16x8*)(wg + (size_t)r * DM + kk * 32 + q * 8);
      acc = __builtin_amdgcn_mfma_f32_16x16x32_bf16(af, bfr, acc, 0, 0, 0);
    }
    ss += __shfl_xor(ss, 16);
    ss += __shfl_xor(ss, 32);
    float rsv = rsqrtf(ss * (1.f / DM) + EPS);
    if (q == 0) rs[row] = rsv;
    float bias = p.b_if[layer * 16 + r];
#pragma unroll
    for (int j = 0; j < 4; ++j) {
      float rr = __shfl(rsv, q * 4 + j);
      gates[(size_t)(rt * 16 + q * 4 + j) * 16 + r] = acc[j] * rr + bias;
    }
  }
}

__device__ __forceinline__ void phase_final(const Params& p, int wave) {
  int lane = fresh_lane(), wid = wave;
  int gw = blockIdx.x * 8 + wid, nw = gridDim.x * 8;
  for (int row = gw; row < T; row += nw) {
    float* xr = p.out + (size_t)row * DM;
    float4 v[8];
    float ss = 0.f;
#pragma unroll
    for (int i = 0; i < 8; ++i) {
      v[i] = *(const float4*)(xr + i * 256 + lane * 4);
      ss += v[i].x * v[i].x + v[i].y * v[i].y + v[i].z * v[i].z + v[i].w * v[i].w;
    }
#pragma unroll
    for (int o = 32; o >= 1; o >>= 1) ss += __shfl_xor(ss, o);
    float rsv = rsqrtf(ss * (1.f / DM) + EPS);
#pragma unroll
    for (int i = 0; i < 8; ++i) {
      float4 g = *(const float4*)(p.final_g + i * 256 + lane * 4);
      float4 o4;
      o4.x = v[i].x * rsv * g.x; o4.y = v[i].y * rsv * g.y; o4.z = v[i].z * rsv * g.z; o4.w = v[i].w * rsv * g.w;
      *(float4*)(xr + i * 256 + lane * 4) = o4;
    }
  }
}

#define LAS __attribute__((address_space(3)))
constexpr int BM = 256, BK = 64, HALF = 128, HTB = HALF * BK * 2, GK = 2048;
typedef f32x4 acc_t[2][2][4][2];
__device__ __forceinline__ int lds_byte(int r, int c) {
  const int st = (r >> 4) * 2 + (c >> 5), rr = r & 15, cc = c & 31, ob = rr * 64 + cc * 2;
  return st * 1024 + (ob ^ (((ob >> 9) & 1) << 5));
}
__device__ __forceinline__ void stage_rc(int b, int& R, int& C) {
  const int st = b / 1024, sb = b % 1024, swz = sb ^ (((sb >> 9) & 1) << 5);
  R = (st >> 1) * 16 + swz / 64;
  C = (st & 1) * 32 + (swz % 64) / 2;
}
__device__ __forceinline__ int perm32(int rho) { const int n = rho >> 4, i = rho & 15; return 8 * (i >> 2) + 4 * n + (i & 3); }
struct Unit { int pm, pn, aux; const char* A; const char* B; };

__device__ __forceinline__ void tile_map(int wgid, int nM, int nN, int& pm, int& pn) {
  int nwg = nM * nN;
  int q = nwg / 8, r = nwg % 8, xcd = wgid % 8, off = wgid / 8;
  wgid = (xcd < r ? xcd * (q + 1) : r * (q + 1) + (xcd - r) * q) + off;
  int nig = 8 * nN, gid = wgid / nig, fm = gid * 8, gsz = min(nM - fm, 8);
  pm = fm + ((wgid % nig) % gsz);
  pn = (wgid % nig) / gsz;
}

template <class Epi, class Sched>
__device__ __forceinline__ void gemm_stream(char* lds_, const Sched& S, const Epi& E, int wave) {
  LAS unsigned char* lds = (LAS unsigned char*)lds_;
  const int lane = fresh_lane(), tid = wave * 64 + lane, wid = wave, wr = wid >> 2, wc = wid & 3, fr = lane & 15, fq = lane >> 4;
  constexpr int K = GK, nt = K / BK;
  unsigned voffA[2], voffB[2];
#pragma unroll
  for (int i = 0; i < 2; ++i) {
    int R, C;
    stage_rc(tid * 16 + i * 8192, R, C);
    const int Rb = Epi::PERM ? ((R & ~31) + perm32(R & 31)) : R;
    voffA[i] = (unsigned)(R * K + C) * 2u;
    voffB[i] = (unsigned)(Rb * K + C) * 2u;
  }
  constexpr size_t kstep = (size_t)(BK * 2), hstep = (size_t)HALF * K * 2;
  const unsigned ldsw = (unsigned)wid * 1024u;
  const int aoff = lds_byte(wr * 64 + fr, fq * 8), boff = lds_byte(wc * 32 + fr, fq * 8);
#define G_SA(b, h) (((b) * 2 + (h)) * HTB)
#define G_SB(b, h) ((4 + (b) * 2 + (h)) * HTB)
#define G_STAGE(bufoff, gbase, voff)                                                                               \
  do {                                                                                                             \
    _Pragma("unroll") for (int _i = 0; _i < 2; ++_i) __builtin_amdgcn_global_load_lds(                             \
        (const unsigned*)((const char*)(gbase) + (voff)[_i]), (LAS unsigned*)(lds + (bufoff) + ldsw + _i * 8192), 16, 0, 0); \
  } while (0)
#define G_LDA(dst, b, h)                                                                                           \
  do {                                                                                                             \
    _Pragma("unroll") for (int m = 0; m < 4; ++m) _Pragma("unroll") for (int k = 0; k < 2; ++k) dst[m][k] =        \
        *(const LAS bf16x8*)(lds + G_SA(b, h) + aoff + m * 2048 + k * 1024);                                       \
  } while (0)
#define G_LDB(dst, b, h)                                                                                           \
  do {                                                                                                             \
    _Pragma("unroll") for (int n = 0; n < 2; ++n) _Pragma("unroll") for (int k = 0; k < 2; ++k) dst[n][k] =        \
        *(const LAS bf16x8*)(lds + G_SB(b, h) + boff + n * 2048 + k * 1024);                                       \
  } while (0)
#define G_MMA(ai, bj, At_, Bt_)                                                                                    \
  do {                                                                                                             \
    __builtin_amdgcn_s_setprio(1);                                                                                 \
    _Pragma("unroll") for (int m = 0; m < 4; ++m) _Pragma("unroll") for (int n = 0; n < 2; ++n)                    \
        _Pragma("unroll") for (int k = 0; k < 2; ++k) acc[ai][bj][m][n] =                                          \
            __builtin_amdgcn_mfma_f32_16x16x32_bf16(Bt_[n][k], At_[m][k], acc[ai][bj][m][n], 0, 0, 0);            \
    __builtin_amdgcn_s_setprio(0);                                                                                 \
  } while (0)
#define G_WAIT_V(n) asm volatile("s_waitcnt vmcnt(" #n ")" ::: "memory")
#define G_WAIT_L(n) asm volatile("s_waitcnt lgkmcnt(" #n ")" ::: "memory")
#define G_BAR __builtin_amdgcn_s_barrier()
#define G_SCHED __builtin_amdgcn_sched_barrier(0)
#define G_ZERO_ACC()                                                                                               \
  do {                                                                                                             \
    _Pragma("unroll") for (int a = 0; a < 2; ++a) _Pragma("unroll") for (int b = 0; b < 2; ++b)                    \
        _Pragma("unroll") for (int m = 0; m < 4; ++m) _Pragma("unroll") for (int n = 0; n < 2; ++n)                \
            acc[a][b][m][n] = (f32x4){0.f, 0.f, 0.f, 0.f};                                                         \
  } while (0)
  Unit cur, nxt;
  int ui = 0;
  if (!S.next(0, cur)) return;
  acc_t acc;
  G_ZERO_ACC();
  bf16x8 At[4][2], B0[2][2], B1[2][2];
  const char* cA = cur.A;
  const char* cB = cur.B;
  G_STAGE(G_SB(0, 0), cB, voffB); G_STAGE(G_SA(0, 0), cA, voffA); G_STAGE(G_SB(0, 1), cB + hstep, voffB); G_STAGE(G_SA(0, 1), cA + hstep, voffA);
  if (wr == 1) G_BAR;
  G_WAIT_V(4); G_BAR;
  G_STAGE(G_SB(1, 0), cB + kstep, voffB); G_STAGE(G_SA(1, 0), cA + kstep, voffA); G_STAGE(G_SB(1, 1), cB + hstep + kstep, voffB);
  G_WAIT_V(6); G_BAR;
  for (;;) {
    const bool has_next = S.next(ui + 1, nxt);
    const char* nA = has_next ? nxt.A : cA;
    const char* nB = has_next ? nxt.B : cB;
    for (int t = 0; t < nt; t += 2) {
      const bool last = (t == nt - 2);
      const char* a1 = cA + (size_t)(t + 1) * kstep;
      const char* a2 = last ? nA : cA + (size_t)(t + 2) * kstep;
      const char* b2 = last ? nB : cB + (size_t)(t + 2) * kstep;
      const char* a3 = a2 + kstep;
      const char* b3 = b2 + kstep;
      G_LDB(B0, 0, 0); G_SCHED; G_LDA(At, 0, 0); G_STAGE(G_SA(1, 1), a1 + hstep, voffA);
      G_WAIT_L(8); G_BAR; G_WAIT_L(0); G_MMA(0, 0, At, B0); G_BAR; G_SCHED;
      G_LDB(B1, 0, 1); G_STAGE(G_SB(0, 0), b2, voffB);
      G_BAR; G_WAIT_L(0); G_MMA(0, 1, At, B1); G_BAR;
      G_LDA(At, 0, 1); G_STAGE(G_SA(0, 0), a2, voffA);
      G_BAR; G_WAIT_L(0); G_MMA(1, 0, At, B0); G_BAR; G_SCHED;
      G_STAGE(G_SB(0, 1), b2 + hstep, voffB);
      G_WAIT_V(6); G_BAR; G_MMA(1, 1, At, B1); G_BAR;
      G_LDB(B0, 1, 0); G_SCHED; G_LDA(At, 1, 0); G_STAGE(G_SA(0, 1), a2 + hstep, voffA);
      G_WAIT_L(8); G_BAR; G_WAIT_L(0); G_MMA(0, 0, At, B0); G_BAR; G_SCHED;
      G_LDB(B1, 1, 1); G_STAGE(G_SB(1, 0), b3, voffB);
      G_BAR; G_WAIT_L(0); G_MMA(0, 1, At, B1); G_BAR;
      G_LDA(At, 1, 1); G_STAGE(G_SA(1, 0), a3, voffA);
      G_BAR; G_WAIT_L(0); G_MMA(1, 0, At, B0); G_BAR; G_SCHED;
      G_STAGE(G_SB(1, 1), b3 + hstep, voffB);
      G_WAIT_V(6); G_BAR; G_MMA(1, 1, At, B1); G_BAR;
    }
    const bool zero = E(acc, cur, wr, wc, fr, fq);
    if (!has_next) break;
    if (zero) G_ZERO_ACC();
    cur = nxt; cA = nA; cB = nB; ++ui;
  }
  G_WAIT_V(0);
  if (wr == 0) G_BAR;
  G_BAR;
#undef G_SA
#undef G_SB
#undef G_STAGE
#undef G_LDA
#undef G_LDB
#undef G_MMA
}

struct SchedIn {
  const char* A; const char* B; int G, c;
  __device__ __forceinline__ bool next(int i, Unit& u) const {
    const int L = i * G + c;
    if (L >= 64 * 64) return false;
    tile_map(L, 64, 64, u.pm, u.pn);
    u.aux = 0;
    u.A = A + (size_t)u.pm * 256 * GK * 2;
    u.B = B + (size_t)u.pn * 256 * GK * 2;
    return true;
  }
};
struct EpiIn {
  static constexpr bool PERM = true;
  unsigned char* ws; const float* rs;
  __device__ __forceinline__ bool operator()(const acc_t& acc, const Unit& u, int wr, int wc, int fr, int fq) const {
    const int bcol = u.pn * 256;
    const int seg = bcol < 1024 ? 0 : bcol < 2048 ? 1 : bcol < 4096 ? 2 : 3 + (bcol - 4096) / 2048;
    const int cbase = seg == 0 ? 0 : seg == 1 ? 1024 : seg == 2 ? 2048 : 4096 + (seg - 3) * 2048;
    const int w = seg < 2 ? 1024 : 2048;
    const size_t off_rm = seg == 0 ? WS_Q : seg == 1 ? WS_K : seg == 3 ? WS_O : seg == 4 ? WS_ZA : seg == 5 ? WS_XBP
                        : seg == 6 ? WS_ZB : seg == 7 ? WS_GA : WS_GB;
    const int row0 = u.pm * 256 + wr * 64 + fr, col0 = bcol - cbase + wc * 32 + 8 * fq;
    u16* dst_rm = (u16*)(ws + off_rm);
    u16* dst_t = (u16*)(ws + (seg == 1 ? WS_KT : WS_VT));
    float scv[2][4];
#pragma unroll
    for (int ai = 0; ai < 2; ++ai)
#pragma unroll
      for (int m = 0; m < 4; ++m) scv[ai][m] = rs[row0 + ai * HALF + m * 16];
    __builtin_amdgcn_sched_barrier(0);
#pragma unroll
    for (int ai = 0; ai < 2; ++ai)
#pragma unroll
      for (int m = 0; m < 4; ++m) {
        const int row = row0 + ai * HALF + m * 16;
        const float sc = scv[ai][m];
#pragma unroll
        for (int bj = 0; bj < 2; ++bj) {
          f32x4 v0 = acc[ai][bj][m][0] * sc, v1 = acc[ai][bj][m][1] * sc;
          u32x4 wv;
          wv.x = cvt_pk_bf16(v0[0], v0[1]); wv.y = cvt_pk_bf16(v0[2], v0[3]);
          wv.z = cvt_pk_bf16(v1[0], v1[1]); wv.w = cvt_pk_bf16(v1[2], v1[3]);
          const int col = col0 + bj * HALF;
          if (seg != 2) *(u32x4*)(dst_rm + (size_t)row * w + col) = wv;
          if (seg == 1 || seg == 2) {
            u16* d = dst_t + ((size_t)(row >> 6) * w + col) * 64 + (row & 63);
            d[0] = (u16)(wv.x & 0xffff); d[64] = (u16)(wv.x >> 16); d[128] = (u16)(wv.y & 0xffff); d[192] = (u16)(wv.y >> 16);
            d[256] = (u16)(wv.z & 0xffff); d[320] = (u16)(wv.z >> 16); d[384] = (u16)(wv.w & 0xffff); d[448] = (u16)(wv.w >> 16);
          }
        }
      }
    return true;
  }
};
__device__ __forceinline__ void phase_inproj(const Params& p, int layer, char* lds, int wave) {
  SchedIn S{(const char*)(p.ws + WS_XB16), (const char*)(p.ws + (layer ? WS_WT1 : WS_WT0)), (int)gridDim.x, (int)blockIdx.x};
  EpiIn E{p.ws, (const float*)(p.ws + WS_RS)};
  gemm_stream(lds, S, E, wave);
}

struct SchedBr {
  const char *YA, *YB, *WA, *WB; int G, c;
  __device__ __forceinline__ bool next(int i, Unit& u) const {
    const int L = (i >> 1) * G + c;
    if (L >= 64 * 8) return false;
    tile_map(L, 64, 8, u.pm, u.pn);
    u.aux = i & 1;
    u.A = (u.aux ? YA : YB) + (size_t)u.pm * 256 * GK * 2;
    u.B = (u.aux ? WA : WB) + (size_t)u.pn * 256 * GK * 2;
    return true;
  }
};
struct EpiBr {
  static constexpr bool PERM = true;
  const u16 *GA, *GB; u16* MG;
  __device__ __forceinline__ bool operator()(acc_t& acc, const Unit& u, int wr, int wc, int fr, int fq) const {
    const int row0 = u.pm * 256 + wr * 64 + fr, col0 = u.pn * 256 + wc * 32 + 8 * fq;
#pragma unroll
    for (int ai = 0; ai < 2; ++ai) {
      bf16x8 gav[4][2], gbv[4][2];
#pragma unroll
      for (int m = 0; m < 4; ++m)
#pragma unroll
        for (int bj = 0; bj < 2; ++bj) {
          const size_t idx = (size_t)(row0 + ai * HALF + m * 16) * DM + col0 + bj * HALF;
          gav[m][bj] = *(const bf16x8*)(GA + idx);
          if (u.aux == 0) gbv[m][bj] = *(const bf16x8*)(GB + idx);
        }
      __builtin_amdgcn_sched_barrier(0);
#pragma unroll
      for (int m = 0; m < 4; ++m)
#pragma unroll
        for (int bj = 0; bj < 2; ++bj) {
          const size_t idx = (size_t)(row0 + ai * HALF + m * 16) * DM + col0 + bj * HALF;
          const bf16x8 ga = gav[m][bj];
          if (u.aux == 0) {
            const bf16x8 gb = gbv[m][bj];
#pragma unroll
            for (int e = 0; e < 8; ++e) {
              float ea = __expf(-bf2f((u16)ga[e])), eb = __expf(-bf2f((u16)gb[e]));
              acc[ai][bj][m][e >> 2][e & 3] *= (1.f + ea) * __builtin_amdgcn_rcpf(1.f + eb);
            }
          } else {
            float o[8];
#pragma unroll
            for (int e = 0; e < 8; ++e) o[e] = acc[ai][bj][m][e >> 2][e & 3] * __builtin_amdgcn_rcpf(1.f + __expf(-bf2f((u16)ga[e])));
            u32x4 wv;
            wv.x = cvt_pk_bf16(o[0], o[1]); wv.y = cvt_pk_bf16(o[2], o[3]); wv.z = cvt_pk_bf16(o[4], o[5]); wv.w = cvt_pk_bf16(o[6], o[7]);
            *(u32x4*)(MG + idx) = wv;
          }
        }
      __builtin_amdgcn_sched_barrier(0);
    }
    return u.aux != 0;
  }
};
__device__ __forceinline__ void phase_branch(const Params& p, int layer, char* lds, int wave) {
  const char* wsm = (const char*)(p.ws + WS_WSM + (size_t)layer * WSM_STRIDE);
  SchedBr S{(const char*)(p.ws + WS_ZA), (const char*)(p.ws + WS_ZB), wsm, wsm + 8 * MiB, (int)gridDim.x, (int)blockIdx.x};
  EpiBr E{(const u16*)(p.ws + WS_GA), (const u16*)(p.ws + WS_GB), (u16*)(p.ws + WS_O)};
  gemm_stream(lds, S, E, wave);
}

struct SchedOut {
  const char *A, *B; int G, c;
  __device__ __forceinline__ bool next(int i, Unit& u) const {
    const int L = i * G + c;
    if (L >= 64 * 8) return false;
    tile_map(L, 64, 8, u.pm, u.pn);
    u.aux = 0;
    u.A = A + (size_t)u.pm * 256 * GK * 2;
    u.B = B + (size_t)u.pn * 256 * GK * 2;
    return true;
  }
};
struct EpiOut {
  static constexpr bool PERM = false;
  const float* xres; float* out;
  __device__ __forceinline__ bool operator()(const acc_t& acc, const Unit& u, int wr, int wc, int fr, int fq) const {
    const int row0 = u.pm * 256 + wr * 64 + fr, col0 = u.pn * 256 + wc * 32 + 4 * fq;
#pragma unroll
    for (int ai = 0; ai < 2; ++ai) {
      f32x4 xv[4][2][2];
#pragma unroll
      for (int m = 0; m < 4; ++m)
#pragma unroll
        for (int bj = 0; bj < 2; ++bj)
#pragma unroll
          for (int n = 0; n < 2; ++n)
            xv[m][bj][n] = *(const f32x4*)(xres + (size_t)(row0 + ai * HALF + m * 16) * DM + col0 + bj * HALF + n * 16);
      __builtin_amdgcn_sched_barrier(0);
#pragma unroll
      for (int m = 0; m < 4; ++m)
#pragma unroll
        for (int bj = 0; bj < 2; ++bj)
#pragma unroll
          for (int n = 0; n < 2; ++n)
            *(f32x4*)(out + (size_t)(row0 + ai * HALF + m * 16) * DM + col0 + bj * HALF + n * 16) = xv[m][bj][n] + acc[ai][bj][m][n];
      __builtin_amdgcn_sched_barrier(0);
    }
    return true;
  }
};
__device__ __forceinline__ void phase_outproj(const Params& p, int layer, char* lds, int wave) {
  SchedOut S{(const char*)(p.ws + WS_O), (const char*)(p.ws + WS_WSM + (size_t)layer * WSM_STRIDE + 16 * MiB), (int)gridDim.x, (int)blockIdx.x};
  EpiOut E{layer == 0 ? p.x : p.out, p.out};
  gemm_stream(lds, S, E, wave);
}

#define MFMA32(a, b, c) __builtin_amdgcn_mfma_f32_32x32x16_bf16(a, b, c, 0, 0, 0)
#define MFMA16(a, b, c) __builtin_amdgcn_mfma_f32_16x16x32_bf16(a, b, c, 0, 0, 0)

__device__ __forceinline__ void mlstm_item(const Params& p, int layer, int grp, int slice, char* lds, int wave) {
  const int b = grp >> 3, hd = (grp >> 1) & 3, dir = grp & 1;
  const int lane = fresh_lane(), tid = wave * 64 + lane, w = wave, r = lane & 31, h = lane >> 5;
  u16* Qs = (u16*)lds;
  u16* Ks = Qs + 64 * 264;
  u16* Kt = Ks + 64 * 264;
  u16* Vt = Kt + 256 * 72;
  u16* Ps = Vt + 64 * 72;
  u16* Cb = Ps + 64 * 72;
  float* vec = (float*)(Cb + 64 * 264);
  float* v_qn = vec + 656, *v_den = vec + 720, *v_n = vec + 784;
  float* Xch = (float*)Ks;
  const u16* gq = (const u16*)(p.ws + WS_Q);
  const u16* gk = (const u16*)(p.ws + WS_K);
  const u16* gkt = (const u16*)(p.ws + WS_KT);
  const u16* gvt = (const u16*)(p.ws + WS_VT);
  const float* gates = (const float*)(p.ws + WS_GATES);
  u16* hdst = (u16*)(p.ws + (dir ? WS_WT0 : WS_XB16));

  bf16x8 pq[4], pk[4], pkt[4], pv;
  float g_i = 0.f, g_f = 0.f, m_st = 0.f;
  const int gw = dir ? 2 : 1;
#define ML_ISSUE(st_)                                                                                          \
  do {                                                                                                         \
    const int chunk_ = dir ? 63 - (st_) : (st_);                                                               \
    const size_t tok_ = (size_t)b * SEQ + chunk_ * 64;                                                         \
    if (w == gw) {                                                                                             \
      const float* gp = gates + (tok_ + (dir ? 63 - lane : lane)) * 16;                                        \
      g_i = gp[dir * 4 + hd];                                                                                  \
      g_f = gp[8 + dir * 4 + hd];                                                                              \
    }                                                                                                          \
    _Pragma("unroll") for (int i = 0; i < 4; ++i) {                                                            \
      int idx = tid + 512 * i, row = idx >> 5, c16 = idx & 31;                                                 \
      pq[i] = *(const bf16x8*)(gq + (tok_ + row) * 1024 + hd * 256 + c16 * 8);                                 \
      pk[i] = *(const bf16x8*)(gk + (tok_ + row) * 1024 + hd * 256 + c16 * 8);                                 \
    }                                                                                                          \
    _Pragma("unroll") for (int i = 0; i < 4; ++i) {                                                            \
      int idx = tid + 512 * i, row = idx >> 3, c16 = idx & 7;                                                  \
      pkt[i] = *(const bf16x8*)(gkt + ((tok_ >> 6) * 1024 + hd * 256 + row) * 64 + c16 * 8);                   \
    }                                                                                                          \
    pv = *(const bf16x8*)(gvt + ((tok_ >> 6) * 2048 + hd * 512 + slice * 64 + (tid >> 3)) * 64 + (tid & 7) * 8); \
  } while (0)
#define ML_GATES(vb_)                                                                                          \
  do {                                                                                                         \
    float* vb = vec + (vb_) * 328;                                                                             \
    const int L = lane, pos = dir ? 63 - L : L;                                                                \
    float lf = fminf(g_f, 0.f) - log1pf(__expf(-fabsf(g_f)));                                                  \
    float bc = lf;                                                                                             \
    _Pragma("unroll") for (int o = 1; o < 64; o <<= 1) { float t = __shfl_up(bc, o); if (L >= o) bc += t; }    \
    float a = g_i - bc;                                                                                        \
    float cm = a;                                                                                              \
    _Pragma("unroll") for (int o = 1; o < 64; o <<= 1) { float t = __shfl_up(cm, o); if (L >= o) cm = fmaxf(cm, t); } \
    float c = fmaxf(m_st, cm);                                                                                 \
    float gtot = __shfl(bc, 63), c63 = __shfl(c, 63);                                                          \
    vb[pos] = a; vb[64 + pos] = c; vb[128 + pos] = __expf(m_st - c); vb[192 + pos] = __expf(-(c + bc));        \
    vb[256 + pos] = __expf(a - c63);                                                                           \
    if (L == 0) vb[320] = __expf(m_st - c63);                                                                  \
    m_st = gtot + c63;                                                                                         \
  } while (0)

  __syncthreads();
  ML_ISSUE(0);
  for (int i = tid; i < 64 * 264; i += 512) Cb[i] = 0;
  if (tid < 256) v_n[tid] = 0.f;
  f32x16 accC[2];
#pragma unroll
  for (int i = 0; i < 16; ++i) { accC[0][i] = 0.f; accC[1][i] = 0.f; }
  if (w == gw) ML_GATES(0);

  for (int st = 0; st < 64; ++st) {
    const int chunk = dir ? 63 - st : st;
    const size_t tok0 = (size_t)b * SEQ + chunk * 64;
    const float* v_a = vec + (st & 1) * 328, *v_c = v_a + 64, *v_wi = v_a + 128, *v_en = v_a + 192, *v_wk = v_a + 256,
               *v_sc = v_a + 320;
    __syncthreads();
#pragma unroll
    for (int i = 0; i < 4; ++i) {
      int idx = tid + 512 * i, row = idx >> 5, c16 = idx & 31;
      *(bf16x8*)(Qs + row * 264 + c16 * 8) = pq[i];
      *(bf16x8*)(Ks + row * 264 + c16 * 8) = pk[i];
    }
#pragma unroll
    for (int i = 0; i < 4; ++i) {
      int idx = tid + 512 * i, row = idx >> 3, c16 = idx & 7;
      *(bf16x8*)(Kt + row * 72 + c16 * 8) = pkt[i];
    }
    *(bf16x8*)(Vt + (tid >> 3) * 72 + (tid & 7) * 8) = pv;
    if (st + 1 < 64) ML_ISSUE(st + 1);
    __syncthreads();
    if (w < 4) {
      int jb = w >> 1, sb = w & 1;
      bool skip = dir ? (sb < jb) : (sb > jb);
      f32x16 sacc;
#pragma unroll
      for (int i = 0; i < 16; ++i) sacc[i] = 0.f;
      if (!skip) {
#pragma unroll 4
        for (int kk = 0; kk < 16; ++kk) {
          bf16x8 af = *(const bf16x8*)(Ks + (sb * 32 + r) * 264 + kk * 16 + h * 8);
          bf16x8 bfr = *(const bf16x8*)(Qs + (jb * 32 + r) * 264 + kk * 16 + h * 8);
          sacc = MFMA32(af, bfr, sacc);
        }
      }
      const int j = jb * 32 + r;
      const float cj = v_c[j];
#pragma unroll
      for (int g = 0; g < 4; ++g) {
        const int sg = sb * 32 + 8 * g + 4 * h;
        const float4 a4 = *(const float4*)(v_a + sg);
        const float av[4] = {a4.x, a4.y, a4.z, a4.w};
        float pv_[4];
#pragma unroll
        for (int i = 0; i < 4; ++i) {
          const int s_ = sg + i;
          const bool valid = (dir ? (s_ >= j) : (s_ <= j)) && !skip;
          pv_[i] = valid ? sacc[4 * g + i] * __expf(av[i] - cj) : 0.f;
        }
        uint2 pk2;
        pk2.x = cvt_pk_bf16(pv_[0], pv_[1]);
        pk2.y = cvt_pk_bf16(pv_[2], pv_[3]);
        *(uint2*)(Ps + j * 72 + sg) = pk2;
      }
      if (w == gw && st + 1 < 64) ML_GATES((st + 1) & 1);
    } else {
      int t2 = tid - 256, j = t2 >> 2, part = t2 & 3;
      float sum = 0.f;
#pragma unroll
      for (int k8 = 0; k8 < 8; ++k8) {
        bf16x8 qv = *(const bf16x8*)(Qs + j * 264 + part * 64 + k8 * 8);
        float4 n0 = *(const float4*)(v_n + part * 64 + k8 * 8), n1 = *(const float4*)(v_n + part * 64 + k8 * 8 + 4);
        sum += bf2f((u16)qv[0]) * n0.x + bf2f((u16)qv[1]) * n0.y + bf2f((u16)qv[2]) * n0.z + bf2f((u16)qv[3]) * n0.w +
               bf2f((u16)qv[4]) * n1.x + bf2f((u16)qv[5]) * n1.y + bf2f((u16)qv[6]) * n1.z + bf2f((u16)qv[7]) * n1.w;
      }
      sum += __shfl_xor(sum, 1);
      sum += __shfl_xor(sum, 2);
      if (part == 0) v_qn[j] = sum;
    }
    __syncthreads();
    {
      int t = w & 3, jb = t >> 1, vb = t & 1, kh = w >> 2;
      const int j = jb * 32 + r;
      f32x16 acc;
#pragma unroll
      for (int i = 0; i < 16; ++i) acc[i] = 0.f;
#pragma unroll 4
      for (int kk = kh * 8; kk < kh * 8 + 8; ++kk) {
        bf16x8 af = *(const bf16x8*)(Cb + (vb * 32 + r) * 264 + kk * 16 + h * 8);
        bf16x8 bfr = *(const bf16x8*)(Qs + (jb * 32 + r) * 264 + kk * 16 + h * 8);
        acc = MFMA32(af, bfr, acc);
      }
      {
        const float wi = v_wi[j];
#pragma unroll
        for (int reg = 0; reg < 16; ++reg) acc[reg] *= wi;
      }
#pragma unroll
      for (int ss = kh * 2; ss < kh * 2 + 2; ++ss) {
        bf16x8 af = *(const bf16x8*)(Vt + (vb * 32 + r) * 72 + ss * 16 + h * 8);
        bf16x8 bfr = *(const bf16x8*)(Ps + (jb * 32 + r) * 72 + ss * 16 + h * 8);
        acc = MFMA32(af, bfr, acc);
      }
      if (kh == 1) {
#pragma unroll
        for (int reg = 0; reg < 16; ++reg) Xch[t * 1024 + reg * 64 + lane] = acc[reg];
        int t2 = tid - 256, jd = t2 >> 2, part = t2 & 3;
        float sum = 0.f;
#pragma unroll
        for (int k8 = 0; k8 < 2; ++k8) {
          bf16x8 pv_ = *(const bf16x8*)(Ps + jd * 72 + part * 16 + k8 * 8);
#pragma unroll
          for (int e = 0; e < 8; ++e) sum += bf2f((u16)pv_[e]);
        }
        sum += __shfl_xor(sum, 1);
        sum += __shfl_xor(sum, 2);
        if (part == 0) v_den[jd] = sum + v_wi[jd] * v_qn[jd];
      }
      __syncthreads();
      if (kh == 0) {
        const float inv = __builtin_amdgcn_rcpf(fmaxf(fabsf(v_den[j]), v_en[j]));
        u16* hrow = hdst + (tok0 + j) * DM + hd * 512 + slice * 64 + vb * 32 + 4 * h;
#pragma unroll
        for (int g = 0; g < 4; ++g) {
          float n0 = (acc[4 * g] + Xch[t * 1024 + (4 * g) * 64 + lane]) * inv;
          float n1 = (acc[4 * g + 1] + Xch[t * 1024 + (4 * g + 1) * 64 + lane]) * inv;
          float n2 = (acc[4 * g + 2] + Xch[t * 1024 + (4 * g + 2) * 64 + lane]) * inv;
          float n3 = (acc[4 * g + 3] + Xch[t * 1024 + (4 * g + 3) * 64 + lane]) * inv;
          uint2 pk2;
          pk2.x = cvt_pk_bf16(n0, n1);
          pk2.y = cvt_pk_bf16(n2, n3);
          *(uint2*)(hrow + 8 * g) = pk2;
        }
      }
    }
    {
      int row = tid >> 3, c16 = tid & 7;
      bf16x8 vv = *(const bf16x8*)(Vt + row * 72 + c16 * 8);
      float4 w0 = *(const float4*)(v_wk + c16 * 8), w1 = *(const float4*)(v_wk + c16 * 8 + 4);
      u32x4 vo;
      vo.x = cvt_pk_bf16(bf2f((u16)vv[0]) * w0.x, bf2f((u16)vv[1]) * w0.y);
      vo.y = cvt_pk_bf16(bf2f((u16)vv[2]) * w0.z, bf2f((u16)vv[3]) * w0.w);
      vo.z = cvt_pk_bf16(bf2f((u16)vv[4]) * w1.x, bf2f((u16)vv[5]) * w1.y);
      vo.w = cvt_pk_bf16(bf2f((u16)vv[6]) * w1.z, bf2f((u16)vv[7]) * w1.w);
      *(u32x4*)(Vt + row * 72 + c16 * 8) = vo;
      if (tid >= 256) {
        int k = tid - 256;
        float sum = v_sc[0] * v_n[k];
#pragma unroll
        for (int k8 = 0; k8 < 8; ++k8) {
          bf16x8 kv = *(const bf16x8*)(Kt + k * 72 + k8 * 8);
          float4 x0 = *(const float4*)(v_wk + k8 * 8), x1 = *(const float4*)(v_wk + k8 * 8 + 4);
          sum += bf2f((u16)kv[0]) * x0.x + bf2f((u16)kv[1]) * x0.y + bf2f((u16)kv[2]) * x0.z + bf2f((u16)kv[3]) * x0.w +
                 bf2f((u16)kv[4]) * x1.x + bf2f((u16)kv[5]) * x1.y + bf2f((u16)kv[6]) * x1.z + bf2f((u16)kv[7]) * x1.w;
        }
        v_n[k] = sum;
      }
    }
    __syncthreads();
    {
      float decay = v_sc[0];
#pragma unroll
      for (int i = 0; i < 16; ++i) { accC[0][i] *= decay; accC[1][i] *= decay; }
#pragma unroll
      for (int ss = 0; ss < 4; ++ss) {
        bf16x8 af = *(const bf16x8*)(Kt + (32 * w + r) * 72 + ss * 16 + h * 8);
        bf16x8 b0 = *(const bf16x8*)(Vt + (r) * 72 + ss * 16 + h * 8);
        bf16x8 b1 = *(const bf16x8*)(Vt + (32 + r) * 72 + ss * 16 + h * 8);
        accC[0] = MFMA32(af, b0, accC[0]);
        accC[1] = MFMA32(af, b1, accC[1]);
      }
#pragma unroll
      for (int vb = 0; vb < 2; ++vb)
#pragma unroll
        for (int g = 0; g < 4; ++g) {
          uint2 pk4;
          pk4.x = cvt_pk_bf16(accC[vb][4 * g], accC[vb][4 * g + 1]);
          pk4.y = cvt_pk_bf16(accC[vb][4 * g + 2], accC[vb][4 * g + 3]);
          *(uint2*)(Cb + (vb * 32 + r) * 264 + 32 * w + 8 * g + 4 * h) = pk4;
        }
    }
  }
  __syncthreads();
#undef ML_ISSUE
#undef ML_GATES
}

template <int dir>
__device__ __forceinline__ void lru_item(const Params& p, int layer, int item, char* lds, int wave) {
  const int b = item >> 6, blk = (item >> 2) & 15, half = item & 1;
  const int lane = fresh_lane(), tid = wave * 64 + lane, w = wave, c = lane & 15, q = lane >> 4;
  const u16* xbp = (const u16*)(p.ws + WS_XBP);
  u16* hdst = (u16*)(p.ws + (dir ? WS_LHB : WS_LHF));
  float* xchg = (float*)(lds + 69632);
  const int cg = tid & 15, tq = tid >> 4;
  float cw[4][8], cbias[8];
#pragma unroll
  for (int e = 0; e < 8; ++e) {
    int chn = blk * 128 + cg * 8 + e;
    cbias[e] = p.conv_b[layer * DM + chn];
#pragma unroll
    for (int tap = 0; tap < 4; ++tap) cw[tap][e] = p.conv_w[(layer * 4 + tap) * DM + chn];
  }
  bf16x8 px[5];
#define LRU_LOAD(ti_)                                                                                      \
  do {                                                                                                     \
    const int s0_ = (dir ? 63 - (ti_) : (ti_)) * 64 + 2 * tq - 2;                                          \
    _Pragma("unroll") for (int rr = 0; rr < 5; ++rr) {                                                     \
      int sp_ = s0_ + rr;                                                                                  \
      bf16x8 z = {0, 0, 0, 0, 0, 0, 0, 0};                                                                 \
      px[rr] = (sp_ >= 0 && sp_ < SEQ) ? *(const bf16x8*)(xbp + ((size_t)b * SEQ + sp_) * DM + blk * 128 + cg * 8) : z; \
    }                                                                                                      \
  } while (0)
#define LRU_CONV(buf_)                                                                                     \
  do {                                                                                                     \
    u16* xcb_ = (u16*)(lds + (buf_) * 17408);                                                              \
    float* xcf_ = (float*)(lds + 34816 + (buf_) * 17408);                                                  \
    _Pragma("unroll") for (int tk = 0; tk < 2; ++tk) {                                                     \
      float xc[8];                                                                                         \
      _Pragma("unroll") for (int e = 0; e < 8; ++e) {                                                      \
        xc[e] = cbias[e] + cw[0][e] * bf2f((u16)px[tk][e]) + cw[1][e] * bf2f((u16)px[tk + 1][e]) +         \
                cw[2][e] * bf2f((u16)px[tk + 2][e]) + cw[3][e] * bf2f((u16)px[tk + 3][e]);                 \
      }                                                                                                    \
      u32x4 o8;                                                                                            \
      o8.x = cvt_pk_bf16(xc[0], xc[1]); o8.y = cvt_pk_bf16(xc[2], xc[3]);                                  \
      o8.z = cvt_pk_bf16(xc[4], xc[5]); o8.w = cvt_pk_bf16(xc[6], xc[7]);                                  \
      const int tt = 2 * tq + tk;                                                                          \
      *(u32x4*)(xcb_ + tt * 136 + cg * 8) = o8;                                                            \
      if ((cg >> 3) == half) {                                                                             \
        float* d = xcf_ + tt * 68 + (cg & 7) * 8;                                                          \
        *(float4*)d = make_float4(xc[0], xc[1], xc[2], xc[3]);                                             \
        *(float4*)(d + 4) = make_float4(xc[4], xc[5], xc[6], xc[7]);                                       \
      }                                                                                                    \
    }                                                                                                      \
  } while (0)
  const int cgp = w & 3, th = w >> 2;
  bf16x8 Br[4], Bi[4];
  const int chl = half * 64 + 16 * cgp + c, ch = blk * 128 + chl;
  {
    const u16* wrg = (const u16*)(p.ws + WS_WSM + (size_t)layer * WSM_STRIDE + 24 * MiB);
    const u16* wr_ = wrg + ((size_t)((dir * 2 + 0) * 16 + blk)) * 16384 + chl * 128;
    const u16* wi_ = wrg + ((size_t)((dir * 2 + 1) * 16 + blk)) * 16384 + chl * 128;
#pragma unroll
    for (int kk = 0; kk < 4; ++kk) {
      Br[kk] = *(const bf16x8*)(wr_ + kk * 32 + q * 8);
      Bi[kk] = *(const bf16x8*)(wi_ + kk * 32 + q * 8);
    }
  }
  const float br = p.b_rg[((layer * 2 + dir) * 2 + 0) * DM + ch];
  const float bi = p.b_rg[((layer * 2 + dir) * 2 + 1) * DM + ch];
  const float lam = p.lam[(layer * 2 + dir) * DM + ch];
  const float sp8 = -8.f * (fmaxf(-lam, 0.f) + log1pf(__expf(-fabsf(lam))));
  float carry = 0.f;
  __syncthreads();
  LRU_LOAD(0);
  LRU_CONV(0);
  LRU_LOAD(1);
  __syncthreads();
  for (int ti = 0; ti < 64; ++ti) {
    if (ti + 1 < 64) {
      LRU_CONV((ti + 1) & 1);
      if (ti + 2 < 64) LRU_LOAD(ti + 2);
    }
    const int tile = dir ? 63 - ti : ti, s0 = tile * 64;
    const u16* xcb = (const u16*)(lds + (ti & 1) * 17408);
    const float* xcf = (const float*)(lds + 34816 + (ti & 1) * 17408);
    float* xo = xchg + (ti & 1) * 256;
    f32x4 ar[2], ai_[2];
#pragma unroll
    for (int mm = 0; mm < 2; ++mm) {
      const int m = 2 * th + mm;
      ar[mm] = f32x4{0.f, 0.f, 0.f, 0.f};
      ai_[mm] = f32x4{0.f, 0.f, 0.f, 0.f};
#pragma unroll
      for (int kk = 0; kk < 4; ++kk) {
        bf16x8 af = *(const bf16x8*)(xcb + (16 * m + c) * 136 + kk * 32 + q * 8);
        ar[mm] = MFMA16(af, Br[kk], ar[mm]);
        ai_[mm] = MFMA16(af, Bi[kk], ai_[mm]);
      }
    }
    float Hh[2][4], Pp[2][4];
    float cH = 0.f, cP = 1.f;
#pragma unroll
    for (int mi = 0; mi < 2; ++mi) {
      const int mm = dir ? 1 - mi : mi, m = 2 * th + mm;
      float a_[4], u_[4];
#pragma unroll
      for (int i = 0; i < 4; ++i) {
        float rg = sigmoidf_(ar[mm][i] + br), ig = sigmoidf_(ai_[mm][i] + bi);
        float a = __expf(sp8 * rg);
        float xv = xcf[(16 * m + 4 * q + i) * 68 + 16 * cgp + c];
        a_[i] = a;
        u_[i] = __builtin_amdgcn_sqrtf(fmaxf(1.f - a * a, 0.f)) * ig * xv;
      }
      float A4 = a_[0] * a_[1] * a_[2] * a_[3];
      float hin = cH, pin = cP;
      if (!dir) {
        float U4 = ((u_[0] * a_[1] + u_[1]) * a_[2] + u_[2]) * a_[3] + u_[3];
#pragma unroll
        for (int qq = 0; qq < 3; ++qq) {
          float Aq = __shfl(A4, qq * 16 + c), Uq = __shfl(U4, qq * 16 + c);
          if (qq < q) { hin = Aq * hin + Uq; pin = Aq * pin; }
        }
        Hh[mm][0] = a_[0] * hin + u_[0];       Pp[mm][0] = a_[0] * pin;
        Hh[mm][1] = a_[1] * Hh[mm][0] + u_[1]; Pp[mm][1] = a_[1] * Pp[mm][0];
        Hh[mm][2] = a_[2] * Hh[mm][1] + u_[2]; Pp[mm][2] = a_[2] * Pp[mm][1];
        Hh[mm][3] = a_[3] * Hh[mm][2] + u_[3]; Pp[mm][3] = a_[3] * Pp[mm][2];
        cH = __shfl(Hh[mm][3], 48 + c);
        cP = __shfl(Pp[mm][3], 48 + c);
      } else {
        float U4 = ((u_[3] * a_[2] + u_[2]) * a_[1] + u_[1]) * a_[0] + u_[0];
#pragma unroll
        for (int qq = 3; qq > 0; --qq) {
          float Aq = __shfl(A4, qq * 16 + c), Uq = __shfl(U4, qq * 16 + c);
          if (qq > q) { hin = Aq * hin + Uq; pin = Aq * pin; }
        }
        Hh[mm][3] = a_[3] * hin + u_[3];       Pp[mm][3] = a_[3] * pin;
        Hh[mm][2] = a_[2] * Hh[mm][3] + u_[2]; Pp[mm][2] = a_[2] * Pp[mm][3];
        Hh[mm][1] = a_[1] * Hh[mm][2] + u_[1]; Pp[mm][1] = a_[1] * Pp[mm][2];
        Hh[mm][0] = a_[0] * Hh[mm][1] + u_[0]; Pp[mm][0] = a_[0] * Pp[mm][1];
        cH = __shfl(Hh[mm][0], c);
        cP = __shfl(Pp[mm][0], c);
      }
    }
    if (q == 0) { xo[(th * 64 + 16 * cgp + c) * 2] = cP; xo[(th * 64 + 16 * cgp + c) * 2 + 1] = cH; }
    __syncthreads();
    {
      const float oP = xo[((1 - th) * 64 + 16 * cgp + c) * 2], oH = xo[((1 - th) * 64 + 16 * cgp + c) * 2 + 1];
      const bool first = dir ? (th == 1) : (th == 0);
      const float cin = first ? carry : (oP * carry + oH);
      carry = first ? (oP * (cP * carry + cH) + oH) : (cP * (oP * carry + oH) + cH);
#pragma unroll
      for (int mm = 0; mm < 2; ++mm)
#pragma unroll
        for (int i = 0; i < 4; ++i)
          hdst[((size_t)b * SEQ + s0 + 16 * (2 * th + mm) + 4 * q + i) * DM + ch] = f2bf(Hh[mm][i] + Pp[mm][i] * cin);
    }
  }
  __syncthreads();
#undef LRU_LOAD
#undef LRU_CONV
}

__device__ __forceinline__ void phase_mixers(const Params& p, int layer, char* lds, int wave) {
  const int n_ml = (PROBE_DUP == 2 && layer == 0) ? 2 : 1, n_lr = (PROBE_DUP == 3 && layer == 0) ? 2 : 1;
  for (int it = blockIdx.x; it < 256; it += gridDim.x) {
    for (int rep = 0; rep < n_ml; ++rep) {
      int j = it >> 3;
      mlstm_item(p, layer, (it & 7) * 4 + (j >> 3), j & 7, lds, wave);
    }
    for (int rep = 0; rep < n_lr; ++rep) {
      if ((it >> 1) & 1) lru_item<1>(p, layer, it, lds, wave);
      else lru_item<0>(p, layer, it, lds, wave);
    }
  }
}

template <bool PROBE = false>
__device__ __forceinline__ void phase_post(const Params& p, int layer, int wave) {
  int lane = fresh_lane(), wid = wave;
  int gw = blockIdx.x * 8 + wid, nw = gridDim.x * 8;
  const u16* hf = (const u16*)(p.ws + WS_XB16);
  const u16* hb = (const u16*)(p.ws + WS_WT0);
  const u16* lf = (const u16*)(p.ws + WS_LHF);
  const u16* lb = (const u16*)(p.ws + WS_LHB);
  const u16* o = (const u16*)(p.ws + WS_O);
  u16* za = (u16*)(p.ws + WS_ZA);
  u16* zb = (u16*)(p.ws + WS_ZB);
  for (int wi0 = gw; wi0 < T * 4; wi0 += 2 * nw) {
    bf16x8 f8[2], b8[2], o8[2], z8[2], lf8[2], lb8[2], zb8[2];
    size_t off[2];
#pragma unroll
    for (int u = 0; u < 2; ++u) {
      int wi = wi0 + u * nw;
      off[u] = (size_t)(wi >> 2) * DM + (wi & 3) * 512 + lane * 8;
      f8[u] = *(const bf16x8*)(hf + off[u]); b8[u] = *(const bf16x8*)(hb + off[u]);
      o8[u] = *(const bf16x8*)(o + off[u]); z8[u] = *(const bf16x8*)(za + off[u]);
      lf8[u] = *(const bf16x8*)(lf + off[u]); lb8[u] = *(const bf16x8*)(lb + off[u]); zb8[u] = *(const bf16x8*)(zb + off[u]);
    }
#pragma unroll
    for (int u = 0; u < 2; ++u) {
      int wi = wi0 + u * nw;
      int col = (wi & 3) * 512 + lane * 8;
      float hv[8], ss = 0.f;
#pragma unroll
      for (int e = 0; e < 8; ++e) { hv[e] = bf2f((u16)f8[u][e]) + bf2f((u16)b8[u][e]); ss += hv[e] * hv[e]; }
#pragma unroll
      for (int s = 32; s >= 1; s >>= 1) ss += __shfl_xor(ss, s);
      float rn = rsqrtf(ss * (1.f / 512.f) + EPS);
      const float4 hg0 = *(const float4*)(p.head_g + layer * DM + col), hg1 = *(const float4*)(p.head_g + layer * DM + col + 4);
      const float hg[8] = {hg0.x, hg0.y, hg0.z, hg0.w, hg1.x, hg1.y, hg1.z, hg1.w};
      float ya[8], yb[8];
#pragma unroll
      for (int e = 0; e < 8; ++e) {
        float ov = bf2f((u16)o8[u][e]), zv = bf2f((u16)z8[u][e]);
        ya[e] = hv[e] * rn * hg[e] * zv * __builtin_amdgcn_rcpf((1.f + __expf(-ov)) * (1.f + __expf(-zv)));
        float zbv = bf2f((u16)zb8[u][e]);
        yb[e] = (bf2f((u16)lf8[u][e]) + bf2f((u16)lb8[u][e])) * zbv * __builtin_amdgcn_rcpf(1.f + __expf(-zbv));
      }
      u32x4 wa, wb;
      wa.x = cvt_pk_bf16(ya[0], ya[1]); wa.y = cvt_pk_bf16(ya[2], ya[3]); wa.z = cvt_pk_bf16(ya[4], ya[5]); wa.w = cvt_pk_bf16(ya[6], ya[7]);
      wb.x = cvt_pk_bf16(yb[0], yb[1]); wb.y = cvt_pk_bf16(yb[2], yb[3]); wb.z = cvt_pk_bf16(yb[4], yb[5]); wb.w = cvt_pk_bf16(yb[6], yb[7]);
      *(u32x4*)((PROBE ? (u16*)(p.ws + WS_Q) : za) + off[u]) = wa;
      *(u32x4*)((PROBE ? (u16*)(p.ws + WS_Q + 64 * MiB) : zb) + off[u]) = wb;
    }
  }
}

#define XB_TMO      128
#define XB_XCNT(j)  (256  + 64 * (j))
#define XB_XSUB(j)  (1280 + 64 * (j))
#define XB_XGEN(j)  (2304 + 64 * (j))
#define XB_TOP      3328
#define XB_TOPGEN   3392
#define XCD_BAR_WORDS 3456
#define XB_SPIN_CAP (1u << 22)
__device__ __forceinline__ unsigned xb_ld(unsigned* p) { return __hip_atomic_load(p, __ATOMIC_RELAXED, __HIP_MEMORY_SCOPE_AGENT); }
__device__ __forceinline__ unsigned xb_add(unsigned* p, unsigned v) { return __hip_atomic_fetch_add(p, v, __ATOMIC_RELAXED, __HIP_MEMORY_SCOPE_AGENT); }
__device__ __forceinline__ unsigned xb_xcc_id() { return (unsigned)__builtin_amdgcn_s_getreg((3 << 11) | 20) & 0xFu; }
#define XB_SPIN(cond, bar) do { unsigned _sp = 0; while (cond) { __builtin_amdgcn_s_sleep(1); \
    if ((++_sp & 255u) == 0u) { if (xb_ld(&(bar)[XB_TMO])) break; if (_sp > XB_SPIN_CAP) { atomicAdd(&(bar)[XB_TMO], 1u); break; } } } } while (0)
__device__ __forceinline__ void xcd_barrier_complete(unsigned* bar, unsigned x, unsigned& nloc, unsigned& nx) {
  const unsigned G = gridDim.x;
  unsigned sum, cnt, mine, sp = 0u;
  for (;;) {
    sum = 0u; cnt = 0u; mine = 0u;
#pragma unroll
    for (unsigned j = 0; j < 16; ++j) { const unsigned c = xb_ld(&bar[XB_XCNT(j)]); sum += c; cnt += (c > 0u) ? 1u : 0u; mine = (j == x) ? c : mine; }
    if (sum == G) break;
    __builtin_amdgcn_s_sleep(1);
    if ((++sp & 255u) == 0u) { if (xb_ld(&bar[XB_TMO])) break; if (sp > XB_SPIN_CAP) { atomicAdd(&bar[XB_TMO], 1u); break; } }
  }
  nloc = mine > 0u ? mine : 1u; nx = cnt > 0u ? cnt : 1u;
}
__device__ __forceinline__ void xcd_barrier(unsigned* bar, unsigned x, volatile LAS unsigned* st, int wave) {
  asm volatile("s_waitcnt vmcnt(0)" ::: "memory");
  __syncthreads();
  if (wave == 0 && fresh_lane() == 0) {
    __builtin_amdgcn_s_waitcnt(0);
    unsigned nloc = st[0], nx = st[1];
    if (nloc == 0u) { xcd_barrier_complete(bar, x, nloc, nx); st[0] = nloc; st[1] = nx; }
    const unsigned old = xb_add(&bar[XB_XSUB(x)], 1u);
    const unsigned gen = old / nloc;
    if (old + 1u == (gen + 1u) * nloc) {
      __builtin_amdgcn_fence(__ATOMIC_RELEASE, "agent");
      asm volatile("s_waitcnt vmcnt(0)" ::: "memory");
      const unsigned og = xb_add(&bar[XB_TOP], 1u);
      const unsigned tg = og / nx;
      if (og + 1u == (tg + 1u) * nx) xb_add(&bar[XB_TOPGEN], 1u);
      else XB_SPIN(xb_ld(&bar[XB_TOPGEN]) == tg, bar);
      __builtin_amdgcn_fence(__ATOMIC_ACQUIRE, "agent");
      xb_add(&bar[XB_XGEN(x)], 1u);
      asm volatile("s_waitcnt vmcnt(0)" ::: "memory");
    } else {
      XB_SPIN(xb_ld(&bar[XB_XGEN(x)]) == gen, bar);
      __builtin_amdgcn_fence(__ATOMIC_ACQUIRE, "agent");
      asm volatile("s_waitcnt vmcnt(0)" ::: "memory");
    }
  }
  __syncthreads();
}

constexpr int NPHASE = 13;
#ifndef XBAR
#define XBAR 1
#endif
#define PH(n, code)                                                            \
  if (ph_lo <= (n) && (n) < ph_hi) {                                           \
    if ((n) > ph_lo) {                                                         \
      if (XBAR && (n) > 1) xcd_barrier(xbar, xcc, xst, wave);                  \
      else cg::this_grid().sync();                                             \
    }                                                                          \
    code;                                                                      \
  }
__global__ void __launch_bounds__(512, 2) mega(Params p, int ph_lo, int ph_hi) {
  extern __shared__ __attribute__((aligned(16))) char lds[];
  const int wave = __builtin_amdgcn_readfirstlane(threadIdx.x >> 6);
  unsigned* xbar = (unsigned*)(p.ws + WS_BAR);
  volatile LAS unsigned* xst = (volatile LAS unsigned*)((LAS unsigned char*)lds + (LDS_BYTES - 16));
  const unsigned xcc = xb_xcc_id();
  if (XBAR) {
    if (threadIdx.x == 0) { xst[0] = 0u; xst[1] = 0u; (void)xb_add(&xbar[XB_XCNT(xcc)], 1u); }
    __syncthreads();
  }
  PH(0, { phase_convert(p, lds, wave); if (PROBE_DUP == 5) phase_convert(p, lds, wave); phase_rowpass<true>(p, 0, p.x, lds, wave); })
  PH(1, { phase_inproj(p, 0, lds, wave); if (PROBE_DUP == 1) { __syncthreads(); phase_inproj(p, 0, lds, wave); } })
  PH(2, phase_mixers(p, 0, lds, wave))
  PH(3, { if (PROBE_DUP == 8) phase_post<true>(p, 0, wave); phase_post(p, 0, wave); })
  PH(4, { phase_branch(p, 0, lds, wave); if (PROBE_DUP == 4) { __syncthreads(); phase_branch(p, 0, lds, wave); } })
  PH(5, phase_outproj(p, 0, lds, wave))
  PH(6, { phase_rowpass<false>(p, 1, p.out, lds, wave);
          if (PROBE_DUP == 6) phase_rowpass<false>(p, 1, p.out, lds, wave);
          if (PROBE_DUP == 7) { for (int i = 0; i < 10; ++i) cg::this_grid().sync(); } })
  PH(7, phase_inproj(p, 1, lds, wave))
  PH(8, phase_mixers(p, 1, lds, wave))
  PH(9, phase_post(p, 1, wave))
  PH(10, phase_branch(p, 1, lds, wave))
  PH(11, phase_outproj(p, 1, lds, wave))
  PH(12, phase_final(p, wave))
}

extern "C" void kernel_launch(void* const* d_in, const int* in_sizes, int n_in, void* d_out, int out_size, void* d_ws,
                              size_t ws_size, hipStream_t stream) {
  static int grid = 0;
  if (grid == 0) {
    if (ws_size < WS_END) { fprintf(stderr, "workspace too small: %zu < %zu\n", ws_size, (size_t)WS_END); grid = -1; return; }
    int dev = 0, cus = 0, per_cu = 0;
    hipGetDevice(&dev);
    hipDeviceGetAttribute(&cus, hipDeviceAttributeMultiprocessorCount, dev);
    if (hipFuncSetAttribute((const void*)mega, hipFuncAttributeMaxDynamicSharedMemorySize, LDS_BYTES) != hipSuccess) {
      fprintf(stderr, "hipFuncSetAttribute failed\n"); grid = -1; return;
    }
    hipOccupancyMaxActiveBlocksPerMultiprocessor(&per_cu, (const void*)mega, 512, LDS_BYTES);
    if (per_cu < 1) { fprintf(stderr, "occupancy query says %d\n", per_cu); per_cu = 1; }
    (void)hipGetLastError();
    grid = cus * 1;
  }
  if (grid < 0) return;
  Params p{};
  p.x = (const float*)d_in[0]; p.norm_g = (const float*)d_in[1]; p.w_in = (const float*)d_in[2];
  p.b_if = (const float*)d_in[3]; p.head_g = (const float*)d_in[4]; p.conv_w = (const float*)d_in[5];
  p.conv_b = (const float*)d_in[6]; p.w_rg = (const float*)d_in[7]; p.b_rg = (const float*)d_in[8];
  p.lam = (const float*)d_in[9]; p.w_a = (const float*)d_in[10]; p.w_b = (const float*)d_in[11];
  p.w_o = (const float*)d_in[12]; p.final_g = (const float*)d_in[13];
  p.out = (float*)d_out; p.ws = (unsigned char*)d_ws;
#if COOP
  if (XBAR) (void)hipMemsetAsync((unsigned char*)d_ws + WS_BAR, 0, XCD_BAR_WORDS * 4, stream);
  int lo = 0, hi = NPHASE;
  void* args[] = {&p, &lo, &hi};
  hipError_t e = hipLaunchCooperativeKernel((const void*)mega, dim3(grid), dim3(512), args, LDS_BYTES, stream);
  if (e != hipSuccess) fprintf(stderr, "cooperative launch failed: %s (grid %d)\n", hipGetErrorString(e), grid);
#else
  for (int ph = 0; ph < NPHASE; ++ph) hipLaunchKernelGGL(mega, dim3(grid), dim3(512), LDS_BYTES, stream, p, ph, ph + 1);
#endif
}
```
